# Optimizing an MI355X kernel written in HIP

```python
import math
import jax, jax.numpy as jnp
from jax import lax
import numpy as np

D_MODEL = 1024
BATCH = 2
SEQ = 8192
DEPTH = 1

GRID_W = 64
CTX_LEN = 256
RET_HEADS = 8
RET_QK_DIM = 64
RET_V_DIM = 128
RET_QK_WIDTH = RET_HEADS * RET_QK_DIM
RET_V_WIDTH = RET_HEADS * RET_V_DIM
CHUNK = 128
POOL_WINDOWS = (2, 4, 8, 16)
POOL_GROUPS = len(POOL_WINDOWS)
POOL_GROUP_DIM = 128
POOL_WIDTH = POOL_GROUPS * POOL_GROUP_DIM
D_FF = 2816
CONV_K = 3
N_MOD = 6
LN_EPS = 1e-6
DEEPNORM_ALPHA = (2.0 * DEPTH) ** 0.25
DEEPNORM_BETA = (8.0 * DEPTH) ** -0.25
IN_SIZES = (RET_QK_WIDTH, RET_V_WIDTH, RET_QK_WIDTH, RET_V_WIDTH, POOL_WIDTH, D_MODEL, D_MODEL)
IN_WIDTH = sum(IN_SIZES)
KV_COLS = RET_QK_WIDTH + RET_V_WIDTH

kernel_name = "hybrid_retention_pool_convffn_dit"


def _layer_norm(x):
    xf = x.astype(jnp.float32)
    mu = jnp.mean(xf, axis=-1, keepdims=True)
    var = jnp.mean(jnp.square(xf - mu), axis=-1, keepdims=True)
    return ((xf - mu) * lax.rsqrt(var + LN_EPS)).astype(x.dtype)


def _modulate(x, shift, scale):
    return _layer_norm(x) * (1.0 + scale) + shift


def _post_norm(z, g, b):
    return _layer_norm(z) * g + b


def _split_in(proj):
    offs = np.cumsum((0,) + IN_SIZES)
    return [proj[..., int(offs[i]):int(offs[i + 1])] for i in range(len(IN_SIZES))]


def _ret_kv(k, v):
    kh = k.reshape(k.shape[0], k.shape[1], RET_HEADS, RET_QK_DIM).astype(jnp.float32) * RET_QK_DIM ** -0.5
    vh = v.reshape(v.shape[0], v.shape[1], RET_HEADS, RET_V_DIM).astype(jnp.float32)
    return kh, vh


def _context_states(kh, vh, lg):
    Lc = kh.shape[1]
    pos = jnp.arange(Lc, dtype=jnp.float32)
    w_f = jnp.exp((Lc - 1 - pos)[:, None] * lg[0][None, :])
    w_b = jnp.exp(pos[:, None] * lg[1][None, :])
    s_f = jnp.einsum('bjhd,jh,bjhe->bhde', kh, w_f, vh)
    s_b = jnp.einsum('bjhd,jh,bjhe->bhde', kh, w_b, vh)
    return s_f, s_b


def _retention_scan(q, k, v, log_gamma, s0):
    B, L, H, dk = q.shape
    dv = v.shape[-1]
    n = L // CHUNK
    qc = q.reshape(B, n, CHUNK, H, dk)
    kc = k.reshape(B, n, CHUNK, H, dk)
    vc = v.reshape(B, n, CHUNK, H, dv)
    pos = jnp.arange(CHUNK, dtype=jnp.float32)
    diff = pos[:, None] - pos[None, :]
    decay_in = jnp.where(diff[None] >= 0,
                         jnp.exp(jnp.maximum(diff, 0.0)[None] * log_gamma[:, None, None]), 0.0)
    scores = jnp.einsum('bnihd,bnjhd->bnhij', qc, kc) * decay_in
    intra = jnp.einsum('bnhij,bnjhe->bnihe', scores, vc)
    q_dec = jnp.exp((pos + 1.0)[:, None] * log_gamma[None, :])
    k_dec = jnp.exp((CHUNK - 1.0 - pos)[:, None] * log_gamma[None, :])
    chunk_dec = jnp.exp(CHUNK * log_gamma)[None, :, None, None]
    kv = jnp.einsum('bnjhd,jh,bnjhe->nbhde', kc, k_dec, vc)

    def step(s, kv_n):
        return chunk_dec * s + kv_n, s

    _, s_prev = lax.scan(step, s0.astype(jnp.float32), kv)
    cross = jnp.einsum('bnihd,ih,nbhde->bnihe', qc, q_dec, s_prev)
    return (intra + cross).reshape(B, L, H, dv)


def _retention_branch(q, k, v, g, s_f, s_b, lg):
    B, L, _ = q.shape
    qh = q.reshape(B, L, RET_HEADS, RET_QK_DIM).astype(jnp.float32)
    kh, vh = _ret_kv(k, v)
    fwd = _retention_scan(qh, kh, vh, lg[0], s_f)
    bwd = jnp.flip(_retention_scan(jnp.flip(qh, 1), jnp.flip(kh, 1), jnp.flip(vh, 1), lg[1], s_b), 1)
    y = fwd + bwd
    mu = jnp.mean(y, axis=-1, keepdims=True)
    var = jnp.mean(jnp.square(y - mu), axis=-1, keepdims=True)
    y = ((y - mu) * lax.rsqrt(var + LN_EPS)).reshape(B, L, RET_V_WIDTH)
    return (y * jax.nn.silu(g.astype(jnp.float32))).astype(g.dtype)


def _pool_mixer(p, pool_w, pool_scale):
    B, L, _ = p.shape
    pf = p.astype(jnp.float32)
    csum = jnp.concatenate([jnp.zeros((B, 1, POOL_WIDTH), jnp.float32), jnp.cumsum(pf, axis=1)], axis=1)
    t = jnp.arange(L)
    outs = []
    for gi, w in enumerate(POOL_WINDOWS):
        lo = jnp.clip(t - w // 2, 0, L)
        hi = jnp.clip(t + w // 2, 0, L)
        cs = csum[:, :, gi * POOL_GROUP_DIM:(gi + 1) * POOL_GROUP_DIM]
        mean = (cs[:, hi] - cs[:, lo]) / (hi - lo).astype(jnp.float32)[None, :, None]
        diff = (mean - pf[:, :, gi * POOL_GROUP_DIM:(gi + 1) * POOL_GROUP_DIM]).astype(p.dtype)
        outs.append(diff @ pool_w[gi])
    return jnp.concatenate(outs, axis=-1) * pool_scale


def _token_mixer(proj, s_f, s_b, lg, pool_w, pool_scale, w_branch_ret, w_branch_pool, w_out):
    k, v, q, g, p_in, gate_a, gate_b = _split_in(proj)
    ret = _retention_branch(q, k, v, g, s_f, s_b, lg) @ w_branch_ret
    pool = _pool_mixer(p_in, pool_w, pool_scale) @ w_branch_pool
    merged = jax.nn.sigmoid(gate_a) * ret + jax.nn.sigmoid(gate_b) * pool
    return merged @ w_out


def _conv_ffn(u, rows, cols, w_up, conv_w, conv_b, w_down):
    B, L, _ = u.shape
    h = (u @ w_up).reshape(B, rows, cols, 2 * D_FF)
    h = lax.conv_general_dilated(h, conv_w[:, :, None, :], (1, 1), 'SAME',
                                 dimension_numbers=('NHWC', 'HWIO', 'NHWC'),
                                 feature_group_count=2 * D_FF) + conv_b
    a, b = jnp.split(h.reshape(B, L, 2 * D_FF), 2, axis=-1)
    return (jax.nn.gelu(a) * b) @ w_down


def _layer(x, ctx, c, c_ctx, w_ada, b_ada, w_in, ret_decay_logit, pool_w, pool_scale,
           w_branch_ret, w_branch_pool, w_out, ln1_g, ln1_b, w_up, conv_w, conv_b, w_down,
           ln2_g, ln2_b, update_ctx):
    B, L, _ = x.shape
    rows = L // GRID_W
    Lc = ctx.shape[1]
    mod = jax.nn.silu(c) @ w_ada + b_ada
    mod_c = jax.nn.silu(c_ctx) @ w_ada + b_ada
    sh1, sc1, g1, sh2, sc2, g2 = jnp.split(mod[:, None, :], N_MOD, axis=-1)
    sh1c, sc1c, g1c, sh2c, sc2c, g2c = jnp.split(mod_c, N_MOD, axis=-1)
    lg = jax.nn.log_sigmoid(ret_decay_logit.astype(jnp.float32))

    uc = _modulate(ctx, sh1c, sc1c)
    if update_ctx:
        projc = uc @ w_in
        kvc = projc[..., :KV_COLS]
    else:
        kvc = uc @ w_in[:, :KV_COLS]
    kc, vc = _ret_kv(kvc[..., :RET_QK_WIDTH], kvc[..., RET_QK_WIDTH:])
    s_f, s_b = _context_states(kc, vc, lg)

    u = _modulate(x, sh1, sc1)
    mix = _token_mixer(u @ w_in, s_f, s_b, lg, pool_w, pool_scale, w_branch_ret, w_branch_pool, w_out)
    x = _post_norm(DEEPNORM_ALPHA * x + g1 * mix, ln1_g, ln1_b)
    u2 = _modulate(x, sh2, sc2)
    x = _post_norm(DEEPNORM_ALPHA * x + g2 * _conv_ffn(u2, rows, GRID_W, w_up, conv_w, conv_b, w_down),
                   ln2_g, ln2_b)

    if update_ctx:
        zero_state = jnp.zeros((B, RET_HEADS, RET_QK_DIM, RET_V_DIM), jnp.float32)
        mix_c = _token_mixer(projc, zero_state, zero_state, lg, pool_w, pool_scale,
                             w_branch_ret, w_branch_pool, w_out)
        ctx = _post_norm(DEEPNORM_ALPHA * ctx + g1c * mix_c, ln1_g, ln1_b)
        u2c = _modulate(ctx, sh2c, sc2c)
        ctx = _post_norm(DEEPNORM_ALPHA * ctx + g2c * _conv_ffn(u2c, 1, Lc, w_up, conv_w, conv_b, w_down),
                         ln2_g, ln2_b)
    return x, ctx


def setup_inputs(seed: int = 0) -> dict:
    key = jax.random.key(seed)
    ks = jax.random.split(key, 24)
    D = D_MODEL
    nrm = lambda k, shape, s: jax.random.normal(k, shape, jnp.float32) * s
    base_logit = jnp.log(2.0 ** (5.0 + jnp.arange(RET_HEADS, dtype=jnp.float32)) - 1.0)
    return {
        "x": nrm(ks[0], (BATCH, SEQ, D), 1.0),
        "c": nrm(ks[1], (BATCH, D), 1.0),
        "ctx": nrm(ks[2], (BATCH, CTX_LEN, D), 1.0),
        "c_ctx": nrm(ks[3], (D,), 1.0),
        "w_ada": nrm(ks[4], (DEPTH, D, N_MOD * D), D ** -0.5),
        "b_ada": nrm(ks[5], (DEPTH, N_MOD * D), 0.02),
        "w_in": nrm(ks[6], (DEPTH, D, IN_WIDTH), D ** -0.5),
        "ret_decay_logit": base_logit[None, None, :] + nrm(ks[7], (DEPTH, 2, RET_HEADS), 0.05),
        "pool_w": nrm(ks[8], (DEPTH, POOL_GROUPS, POOL_GROUP_DIM, POOL_GROUP_DIM), POOL_GROUP_DIM ** -0.5),
        "pool_scale": 1.0 + nrm(ks[9], (DEPTH, POOL_WIDTH), 0.1),
        "w_branch_ret": nrm(ks[10], (DEPTH, RET_V_WIDTH, D), RET_V_WIDTH ** -0.5),
        "w_branch_pool": nrm(ks[11], (DEPTH, POOL_WIDTH, D), POOL_WIDTH ** -0.5),
        "w_out": nrm(ks[12], (DEPTH, D, D), D ** -0.5 * DEEPNORM_BETA),
        "ln1_g": 1.0 + nrm(ks[13], (DEPTH, D), 0.02),
        "ln1_b": nrm(ks[14], (DEPTH, D), 0.02),
        "w_up": nrm(ks[15], (DEPTH, D, 2 * D_FF), D ** -0.5),
        "conv_w": nrm(ks[16], (DEPTH, CONV_K, CONV_K, 2 * D_FF), 1.0 / CONV_K),
        "conv_b": nrm(ks[17], (DEPTH, 2 * D_FF), 0.02),
        "w_down": nrm(ks[18], (DEPTH, D_FF, D), D_FF ** -0.5 * DEEPNORM_BETA),
        "ln2_g": 1.0 + nrm(ks[19], (DEPTH, D), 0.02),
        "ln2_b": nrm(ks[20], (DEPTH, D), 0.02),
    }


def reference(x, c, ctx, c_ctx, w_ada, b_ada, w_in, ret_decay_logit, pool_w, pool_scale,
              w_branch_ret, w_branch_pool, w_out, ln1_g, ln1_b, w_up, conv_w, conv_b, w_down,
              ln2_g, ln2_b):
    for l in range(DEPTH):
        x, ctx = _layer(x, ctx, c, c_ctx, w_ada[l], b_ada[l], w_in[l], ret_decay_logit[l], pool_w[l],
                        pool_scale[l], w_branch_ret[l], w_branch_pool[l], w_out[l], ln1_g[l], ln1_b[l],
                        w_up[l], conv_w[l], conv_b[l], w_down[l], ln2_g[l], ln2_b[l],
                        update_ctx=(l < DEPTH - 1))
    return x
```

```cpp
#include <hip/hip_runtime.h>
#include <hip/hip_cooperative_groups.h>
#include <cstdio>
#include <cstdint>
namespace cg = cooperative_groups;
namespace pg8 {
#define PG8_LAS __attribute__((address_space(3)))
typedef unsigned short bf16_t;
typedef short bf16x8 __attribute__((ext_vector_type(8)));
typedef float f32x4 __attribute__((ext_vector_type(4)));
typedef unsigned u32x4 __attribute__((ext_vector_type(4)));
constexpr int BM = 256, BK = 64, HALF = 128, HTB = HALF * BK * 2  , STAGE_BYTES = 8 * HTB, NXCD = 8, WGM = 8;

__host__ __device__ __forceinline__ int lds_byte(int r, int c) { const int st = (r >> 4) * 2 + (c >> 5), rr = r & 15, cc = c & 31, ob = rr * 64 + cc * 2; return st * 1024 + (ob ^ (((ob >> 9) & 1) << 5)); }
__host__ __device__ __forceinline__ void stage_rc(int b, int& R, int& C) { const int st = b / 1024, sb = b % 1024, swz = sb ^ (((sb >> 9) & 1) << 5); R = (st >> 1) * 16 + swz / 64; C = (st & 1) * 32 + (swz % 64) / 2; }
__host__ __device__ __forceinline__ int perm32(int rho) { const int n = rho >> 4, i = rho & 15; return 8 * (i >> 2) + 4 * n + (i & 3); }

struct Unit { int pm, pn; };
struct Gemm { const bf16_t* A; const bf16_t* Bt; int lda, M, N, K; };

struct StaticOrder {
    int nM, nN, nwg, G, c;
    __host__ __device__ void init(int M, int N, int G_, int c_) { nM = M / BM; nN = N / BM; nwg = nM * nN; G = G_; c = c_; }
    __host__ __device__ bool next(int i, Unit& u) const {
        const long L = (long)i * G + c; if (L >= nwg) return false;
        int wgid = (int)L; { const int q = nwg / NXCD, r = nwg % NXCD, xcd = wgid % NXCD, off = wgid / NXCD; wgid = (xcd < r ? xcd * (q + 1) : r * (q + 1) + (xcd - r) * q) + off; }
        const int nig = WGM * nN, gid = wgid / nig, fm = gid * WGM, gsz = (nM - fm) < WGM ? (nM - fm) : WGM;
        u.pm = fm + ((wgid % nig) % gsz); u.pn = (wgid % nig) / gsz; return true;
    }
    __device__ __forceinline__ void a_ready(const Unit&) const {}
    __device__ __forceinline__ void done(const Unit&) const {}
};

__device__ __forceinline__ unsigned cvt_pk_bf16(float lo, float hi) { unsigned r; asm volatile("v_cvt_pk_bf16_f32 %0, %1, %2" : "=v"(r) : "v"(lo), "v"(hi)); return r; }
template <class Epi, class Sched, bool ALIGN_EPI = false, bool SP2 = false>
__device__ __forceinline__ void gemm_phase(PG8_LAS unsigned char* lds, const Gemm g, const Sched& S, const Epi& E) {
    int tid_ = threadIdx.x; asm volatile("" : "+v"(tid_));
    const int tid = tid_, wid = __builtin_amdgcn_readfirstlane(tid >> 6), lane = tid & 63, wr = wid >> 2, wc = wid & 3, fr = lane & 15, fq = lane >> 4;
    const int K = g.K, nt = K / BK;
    unsigned voffA[2], voffB[2];
#pragma unroll
    for (int i = 0; i < 2; ++i) { int R, C; stage_rc(tid * 16 + i * 8192, R, C); const int Rb = Epi::PERM ? ((R & ~31) + perm32(R & 31)) : R;
        voffA[i] = (unsigned)(R * g.lda + C) * 2u; voffB[i] = (unsigned)(Rb * K + C) * 2u; }
    const size_t kstep = (size_t)(BK * 2);
    const size_t hstep = (size_t)HALF * K * 2, hstepA = (size_t)HALF * g.lda * 2;
    const size_t tstep = 2 * hstep, tstepA = 2 * hstepA;
    const unsigned ldsw = (unsigned)wid * 1024u;
    const int aoff = lds_byte(wr * 64 + fr, fq * 8), boff = lds_byte(wc * 32 + fr, fq * 8);
#define PG8_SA(b, h) (((b) * 2 + (h)) * HTB)
#define PG8_SB(b, h) ((4 + (b) * 2 + (h)) * HTB)
#define PG8_STAGE(bufoff, gbase, voff) do { _Pragma("unroll") for (int _i = 0; _i < 2; ++_i) \
        __builtin_amdgcn_global_load_lds((const unsigned*)((const char*)(gbase) + (voff)[_i]), (PG8_LAS unsigned*)(lds + (bufoff) + ldsw + _i * 8192), 16, 0, 0); } while (0)
#define PG8_LDA(dst, b, h) do { _Pragma("unroll") for (int m = 0; m < 4; ++m) _Pragma("unroll") for (int k = 0; k < 2; ++k) dst[m][k] = *(const PG8_LAS bf16x8*)(lds + PG8_SA(b, h) + aoff + m * 2048 + k * 1024); } while (0)
#define PG8_LDB(dst, b, h) do { _Pragma("unroll") for (int n = 0; n < 2; ++n) _Pragma("unroll") for (int k = 0; k < 2; ++k) dst[n][k] = *(const PG8_LAS bf16x8*)(lds + PG8_SB(b, h) + boff + n * 2048 + k * 1024); } while (0)
#define PG8_MMA(ai, bj, At, Bt) do { __builtin_amdgcn_s_setprio(1); _Pragma("unroll") for (int m = 0; m < 4; ++m) _Pragma("unroll") for (int n = 0; n < 2; ++n) _Pragma("unroll") for (int k = 0; k < 2; ++k) \
        acc[ai][bj][m][n] = __builtin_amdgcn_mfma_f32_16x16x32_bf16(Bt[n][k], At[m][k], acc[ai][bj][m][n], 0, 0, 0); __builtin_amdgcn_s_setprio(0); } while (0)
#define PG8_WAIT_V(n) asm volatile("s_waitcnt vmcnt(" #n ")" ::: "memory")
#define PG8_WAIT_L(n) asm volatile("s_waitcnt lgkmcnt(" #n ")" ::: "memory")
#define PG8_BAR __builtin_amdgcn_s_barrier()
#define PG8_SCHED __builtin_amdgcn_sched_barrier(0)
    Unit cur, nxt; int ui = 0;
    if (!S.next(0, cur)) return;
    f32x4 acc[2][2][4][2];
#pragma unroll
    for (int a = 0; a < 2; ++a)
#pragma unroll
        for (int b = 0; b < 2; ++b)
#pragma unroll
            for (int m = 0; m < 4; ++m)
#pragma unroll
                for (int n = 0; n < 2; ++n) acc[a][b][m][n] = (f32x4){0.f, 0.f, 0.f, 0.f};
    bf16x8 At[4][2], B0[2][2], B1[2][2];
    const char* cA = (const char*)g.A + (size_t)cur.pm * tstepA; const char* cB = (const char*)g.Bt + (size_t)cur.pn * tstep;
    S.a_ready(cur);
    if constexpr (SP2) {
        PG8_STAGE(PG8_SB(0, 0), cB, voffB); PG8_STAGE(PG8_SB(0, 1), cB + hstep, voffB); PG8_STAGE(PG8_SA(0, 0), cA, voffA); PG8_STAGE(PG8_SA(0, 1), cA + hstepA, voffA);
        if (wr == 1) PG8_BAR;
        PG8_WAIT_V(2); PG8_BAR;
        PG8_STAGE(PG8_SB(1, 0), cB + kstep, voffB); PG8_STAGE(PG8_SA(1, 0), cA + kstep, voffA); PG8_STAGE(PG8_SB(1, 1), cB + hstep + kstep, voffB);
        PG8_WAIT_V(6); PG8_BAR;
    } else {
        PG8_STAGE(PG8_SB(0, 0), cB, voffB); PG8_STAGE(PG8_SA(0, 0), cA, voffA); PG8_STAGE(PG8_SB(0, 1), cB + hstep, voffB); PG8_STAGE(PG8_SA(0, 1), cA + hstepA, voffA);
        if (wr == 1) PG8_BAR;
        PG8_WAIT_V(4); PG8_BAR;
        PG8_STAGE(PG8_SB(1, 0), cB + kstep, voffB); PG8_STAGE(PG8_SA(1, 0), cA + kstep, voffA); PG8_STAGE(PG8_SB(1, 1), cB + hstep + kstep, voffB);
        PG8_WAIT_V(6); PG8_BAR;
    }
    for (;;) {
        const bool has_next = S.next(ui + 1, nxt);
        const char* nA = has_next ? (const char*)g.A + (size_t)nxt.pm * tstepA : cA; const char* nB = has_next ? (const char*)g.Bt + (size_t)nxt.pn * tstep : cB;
        for (int t = 0; t < nt; t += 2) {
            const bool last = (t == nt - 2);
            const char* a1 = cA + (size_t)(t + 1) * kstep;
            const char* a2 = last ? nA : cA + (size_t)(t + 2) * kstep; const char* b2 = last ? nB : cB + (size_t)(t + 2) * kstep;
            const char* a3 = a2 + kstep; const char* b3 = b2 + kstep;
            if (last && has_next) S.a_ready(nxt);
            if constexpr (SP2) {
            PG8_LDB(B0, 0, 0); PG8_LDB(B1, 0, 1); PG8_SCHED; PG8_LDA(At, 0, 0); PG8_STAGE(PG8_SA(1, 1), a1 + hstepA, voffA);
            PG8_WAIT_V(8); PG8_WAIT_L(0); PG8_BAR; PG8_MMA(0, 0, At, B0); PG8_MMA(0, 1, At, B1); PG8_BAR; PG8_SCHED;
            PG8_LDA(At, 0, 1); PG8_STAGE(PG8_SB(0, 0), b2, voffB); PG8_STAGE(PG8_SB(0, 1), b2 + hstep, voffB); PG8_STAGE(PG8_SA(0, 0), a2, voffA);
            PG8_WAIT_V(8); PG8_WAIT_L(0); PG8_BAR; PG8_MMA(1, 0, At, B0); PG8_MMA(1, 1, At, B1); PG8_BAR; PG8_SCHED;
            PG8_LDB(B0, 1, 0); PG8_LDB(B1, 1, 1); PG8_SCHED; PG8_LDA(At, 1, 0); PG8_STAGE(PG8_SA(0, 1), a2 + hstepA, voffA);
            PG8_WAIT_V(8); PG8_WAIT_L(0); PG8_BAR; PG8_MMA(0, 0, At, B0); PG8_MMA(0, 1, At, B1); PG8_BAR; PG8_SCHED;
            PG8_LDA(At, 1, 1); PG8_STAGE(PG8_SB(1, 0), b3, voffB); PG8_STAGE(PG8_SB(1, 1), b3 + hstep, voffB); PG8_STAGE(PG8_SA(1, 0), a3, voffA);
            PG8_WAIT_V(8); PG8_WAIT_L(0); PG8_BAR; PG8_MMA(1, 0, At, B0); PG8_MMA(1, 1, At, B1); PG8_BAR; PG8_SCHED;
            } else {
            PG8_LDB(B0, 0, 0); PG8_SCHED; PG8_LDA(At, 0, 0); PG8_STAGE(PG8_SA(1, 1), a1 + hstepA, voffA);
            PG8_WAIT_L(8); PG8_BAR; PG8_WAIT_L(0); PG8_MMA(0, 0, At, B0); PG8_BAR; PG8_SCHED;
            PG8_LDB(B1, 0, 1); PG8_STAGE(PG8_SB(0, 0), b2, voffB);
            PG8_BAR; PG8_WAIT_L(0); PG8_MMA(0, 1, At, B1); PG8_BAR;
            PG8_LDA(At, 0, 1); PG8_STAGE(PG8_SA(0, 0), a2, voffA);
            PG8_BAR; PG8_WAIT_L(0); PG8_MMA(1, 0, At, B0); PG8_BAR; PG8_SCHED;
            PG8_STAGE(PG8_SB(0, 1), b2 + hstep, voffB);
            PG8_WAIT_V(6); PG8_BAR; PG8_MMA(1, 1, At, B1); PG8_BAR;
            PG8_LDB(B0, 1, 0); PG8_SCHED; PG8_LDA(At, 1, 0); PG8_STAGE(PG8_SA(0, 1), a2 + hstepA, voffA);
            PG8_WAIT_L(8); PG8_BAR; PG8_WAIT_L(0); PG8_MMA(0, 0, At, B0); PG8_BAR; PG8_SCHED;
            PG8_LDB(B1, 1, 1); PG8_STAGE(PG8_SB(1, 0), b3, voffB);
            PG8_BAR; PG8_WAIT_L(0); PG8_MMA(0, 1, At, B1); PG8_BAR;
            PG8_LDA(At, 1, 1); PG8_STAGE(PG8_SA(1, 0), a3, voffA);
            PG8_BAR; PG8_WAIT_L(0); PG8_MMA(1, 0, At, B0); PG8_BAR; PG8_SCHED;
            PG8_STAGE(PG8_SB(1, 1), b3 + hstep, voffB);
            PG8_WAIT_V(6); PG8_BAR; PG8_MMA(1, 1, At, B1); PG8_BAR;
            }
        }
        if constexpr (ALIGN_EPI) { if (wr == 0) PG8_BAR; }
        if constexpr (!Epi::AFTER_DRAIN) { E(acc, cur, wr, wc, fr, fq); S.done(cur); }
        if (!has_next) break;
#pragma unroll
        for (int a = 0; a < 2; ++a)
#pragma unroll
            for (int b = 0; b < 2; ++b)
#pragma unroll
                for (int m = 0; m < 4; ++m)
#pragma unroll
                    for (int n = 0; n < 2; ++n) acc[a][b][m][n] = (f32x4){0.f, 0.f, 0.f, 0.f};
        cur = nxt; cA = nA; cB = nB; ++ui;
        if constexpr (ALIGN_EPI) { if (wr == 1) PG8_BAR; }
    }
    PG8_WAIT_V(0);
    if constexpr (!ALIGN_EPI) { if (wr == 0) PG8_BAR; }
    PG8_BAR;
    if constexpr (Epi::AFTER_DRAIN) { E.fused(acc, cur, wr, wc, fr, fq, lds, wid, lane); S.done(cur); }
#undef PG8_SA
#undef PG8_SB
#undef PG8_STAGE
#undef PG8_LDA
#undef PG8_LDB
#undef PG8_MMA
#undef PG8_WAIT_V
#undef PG8_WAIT_L
#undef PG8_BAR
#undef PG8_SCHED
}
}

#define LAS __attribute__((address_space(3)))
using pg8::bf16_t; using pg8::bf16x8; using pg8::f32x4; using pg8::u32x4; using pg8::cvt_pk_bf16;
typedef unsigned u32x2 __attribute__((ext_vector_type(2)));

constexpr int NTHR = 512, NWAVES = 8;
constexpr int D = 1024, SEQ = 8192, BATCH = 2, MTOK = BATCH * SEQ, CTXL = 256, MCTX = BATCH * CTXL;
constexpr int HEADS = 8, DK = 64, DV = 128, NCH = SEQ / 128;
constexpr int INW = 5632, KVC = 1536, DFF = 2816, UPW = 2 * DFF, NMOD = 6 * D;
constexpr int C_K = 0, C_V = 512, C_Q = 1536, C_G = 2048, C_P = 3072, C_GA = 3584, C_GB = 4608;
constexpr float LN_EPS = 1e-6f;
constexpr float DN_ALPHA = 1.18920711500272f;
constexpr int KSPLIT = 8;

constexpr size_t MiB = 1u << 20;
constexpr size_t WS_MODP = 64 * 1024, WS_MOD = 1 * MiB;
constexpr size_t WS_WUP = 2 * MiB, WS_WDN = 13 * MiB, WS_WBR = 19 * MiB, WS_WBP = 21 * MiB, WS_WOUT = 22 * MiB, WS_PW = 24 * MiB;
constexpr size_t WS_U = 25 * MiB, WS_KVF = 25 * MiB, WS_KVB = 41 * MiB;
constexpr size_t WS_UC = 57 * MiB, WS_PROJC = 58 * MiB, WS_CKV = 60 * MiB;
constexpr size_t WS_WIN = 61 * MiB, WS_POOL = 61 * MiB;
constexpr size_t WS_PROJ = 80 * MiB, WS_H = 80 * MiB, WS_HC = 168 * MiB, WS_END = 256 * MiB;
constexpr int LDS_BYTES = 147456;

struct Params { const float* in[21]; float* out; unsigned char* ws; int ph_lo, ph_hi; };
enum { I_X = 0, I_C, I_CTX, I_CCTX, I_WADA, I_BADA, I_WIN, I_DECAY, I_POOLW, I_POOLS, I_WBR, I_WBP, I_WOUT, I_LN1G, I_LN1B, I_WUP, I_CONVW, I_CONVB, I_WDN, I_LN2G, I_LN2B };

__device__ __forceinline__ unsigned f2bf(float f) { unsigned u = __builtin_bit_cast(unsigned, f); return (u + 0x7fffu + ((u >> 16) & 1u)) >> 16; }
__device__ __forceinline__ float bflo(unsigned w) { return __builtin_bit_cast(float, w << 16); }
__device__ __forceinline__ float bfhi(unsigned w) { return __builtin_bit_cast(float, w & 0xffff0000u); }
__device__ __forceinline__ float sigmoidf_(float x) { return 1.0f / (1.0f + __expf(-x)); }
__device__ __forceinline__ float wave_sum(float v) {
#pragma unroll
    for (int o = 1; o < 64; o <<= 1) v += __shfl_xor(v, o);
    return v;
}
#define LDS_WAIT() asm volatile("s_waitcnt lgkmcnt(0)" ::: "memory")
__device__ __forceinline__ bf16x8 mk8(u32x2 lo, u32x2 hi) { u32x4 w = {lo.x, lo.y, hi.x, hi.y}; return __builtin_bit_cast(bf16x8, w); }
#define MFMA16(a, b, c) __builtin_amdgcn_mfma_f32_16x16x32_bf16((a), (b), (c), 0, 0, 0)

struct EpiStoreBf16 {
    static constexpr bool PERM = true, AFTER_DRAIN = false;
    bf16_t* O; int ldc;
    __device__ __forceinline__ void operator()(const f32x4 (&acc)[2][2][4][2], const pg8::Unit& u, int wr, int wc, int fr, int fq) const {
        const int row0 = u.pm * 256 + wr * 64 + fr, col0 = u.pn * 256 + wc * 32 + 8 * fq;
#pragma unroll
        for (int ai = 0; ai < 2; ++ai)
#pragma unroll
            for (int m = 0; m < 4; ++m) { bf16_t* rowp = O + (size_t)(row0 + ai * 128 + m * 16) * ldc + col0;
#pragma unroll
                for (int bj = 0; bj < 2; ++bj) { const f32x4 v0 = acc[ai][bj][m][0], v1 = acc[ai][bj][m][1];
                    u32x4 w; w.x = cvt_pk_bf16(v0[0], v0[1]); w.y = cvt_pk_bf16(v0[2], v0[3]); w.z = cvt_pk_bf16(v1[0], v1[1]); w.w = cvt_pk_bf16(v1[2], v1[3]);
                    *(u32x4*)(rowp + bj * 128) = w; } }
    }
};
template <int MODE> struct EpiGate {
    static constexpr bool PERM = true, AFTER_DRAIN = false;
    bf16_t* Mg; const bf16_t* Gb; int ldc;
    __device__ __forceinline__ void operator()(const f32x4 (&acc)[2][2][4][2], const pg8::Unit& u, int wr, int wc, int fr, int fq) const {
        const int row0 = u.pm * 256 + wr * 64 + fr, col0 = u.pn * 256 + wc * 32 + 8 * fq;
#pragma unroll
        for (int ai = 0; ai < 2; ++ai)
#pragma unroll
            for (int m = 0; m < 4; ++m) { const size_t off = (size_t)(row0 + ai * 128 + m * 16) * ldc + col0;
#pragma unroll
                for (int bj = 0; bj < 2; ++bj) { const f32x4 v0 = acc[ai][bj][m][0], v1 = acc[ai][bj][m][1];
                    const u32x4 mg = *(const u32x4*)(Mg + off + bj * 128);
                    float r[8];
                    if (MODE == 0) {
                        r[0] = sigmoidf_(bflo(mg.x)) * v0[0]; r[1] = sigmoidf_(bfhi(mg.x)) * v0[1]; r[2] = sigmoidf_(bflo(mg.y)) * v0[2]; r[3] = sigmoidf_(bfhi(mg.y)) * v0[3];
                        r[4] = sigmoidf_(bflo(mg.z)) * v1[0]; r[5] = sigmoidf_(bfhi(mg.z)) * v1[1]; r[6] = sigmoidf_(bflo(mg.w)) * v1[2]; r[7] = sigmoidf_(bfhi(mg.w)) * v1[3];
                    } else {
                        const u32x4 gb = *(const u32x4*)(Gb + off + bj * 128);
                        r[0] = bflo(mg.x) + sigmoidf_(bflo(gb.x)) * v0[0]; r[1] = bfhi(mg.x) + sigmoidf_(bfhi(gb.x)) * v0[1]; r[2] = bflo(mg.y) + sigmoidf_(bflo(gb.y)) * v0[2]; r[3] = bfhi(mg.y) + sigmoidf_(bfhi(gb.y)) * v0[3];
                        r[4] = bflo(mg.z) + sigmoidf_(bflo(gb.z)) * v1[0]; r[5] = bfhi(mg.z) + sigmoidf_(bfhi(gb.z)) * v1[1]; r[6] = bflo(mg.w) + sigmoidf_(bflo(gb.w)) * v1[2]; r[7] = bfhi(mg.w) + sigmoidf_(bfhi(gb.w)) * v1[3];
                    }
                    u32x4 w; w.x = cvt_pk_bf16(r[0], r[1]); w.y = cvt_pk_bf16(r[2], r[3]); w.z = cvt_pk_bf16(r[4], r[5]); w.w = cvt_pk_bf16(r[6], r[7]);
                    *(u32x4*)(Mg + off + bj * 128) = w; } }
    }
};
struct EpiResid {
    static constexpr bool PERM = false, AFTER_DRAIN = false;
    const float* base; float* out; const float* gate;
    __device__ __forceinline__ void operator()(const f32x4 (&acc)[2][2][4][2], const pg8::Unit& u, int wr, int wc, int fr, int fq) const {
        const int row0 = u.pm * 256 + wr * 64 + fr, col0 = u.pn * 256 + wc * 32 + 4 * fq;
        const float* gp = gate + (size_t)((u.pm * 256) / SEQ) * NMOD + col0;
        f32x4 gv[2][2];
#pragma unroll
        for (int bj = 0; bj < 2; ++bj)
#pragma unroll
            for (int n = 0; n < 2; ++n) gv[bj][n] = *(const f32x4*)(gp + bj * 128 + n * 16);
#pragma unroll
        for (int ai = 0; ai < 2; ++ai)
#pragma unroll
            for (int m = 0; m < 4; ++m) { const size_t off = (size_t)(row0 + ai * 128 + m * 16) * D + col0;
#pragma unroll
                for (int bj = 0; bj < 2; ++bj)
#pragma unroll
                    for (int n = 0; n < 2; ++n) { const f32x4 bs = *(const f32x4*)(base + off + bj * 128 + n * 16);
                        *(f32x4*)(out + off + bj * 128 + n * 16) = bs * DN_ALPHA + gv[bj][n] * acc[ai][bj][m][n]; } }
    }
};

__device__ __forceinline__ void p0_transpose_item(const float* W, int K, int N, bf16_t* WT, LAS float* scr, int item, int lane) {
    const int nblk = N / 32, kb = item / nblk, nb = item % nblk, k0 = 64 * kb, n0 = 32 * nb;
#pragma unroll 8
    for (int i = 0; i < 32; ++i) { const int kk = 2 * i + (lane >> 5); scr[kk * 33 + (lane & 31)] = W[(size_t)(k0 + kk) * N + n0 + (lane & 31)]; }
    LDS_WAIT(); asm volatile("" ::: "memory");
    const int c = lane & 7;
#pragma unroll
    for (int j = 0; j < 4; ++j) { const int n = (lane >> 3) + 8 * j; const LAS float* s = scr + (8 * c) * 33 + n;
        u32x4 o; o.x = cvt_pk_bf16(s[0 * 33], s[1 * 33]); o.y = cvt_pk_bf16(s[2 * 33], s[3 * 33]); o.z = cvt_pk_bf16(s[4 * 33], s[5 * 33]); o.w = cvt_pk_bf16(s[6 * 33], s[7 * 33]);
        *(u32x4*)(WT + (size_t)(n0 + n) * K + k0 + 8 * c) = o; }
    LDS_WAIT(); asm volatile("" ::: "memory");
}
__device__ __forceinline__ float siluf_(float x) { return x / (1.0f + __expf(-x)); }

__device__ __forceinline__ void phase_prep(const Params& p, LAS unsigned char* L, int G, int bid, int wave, int lane) {
    LAS float* scr = (LAS float*)(L + wave * 16384);
    unsigned char* ws = p.ws;
    constexpr int I_IN = 16 * 176, I_UP = 16 * 176, I_DN = 44 * 32, I_BR = 16 * 32, I_BP = 8 * 32, I_OUT = 16 * 32, I_PW1 = 2 * 4, I_MOD = (NMOD / 64) * KSPLIT;
    constexpr int NITEMS = I_IN + I_UP + I_DN + I_BR + I_BP + I_OUT + 4 * I_PW1 + I_MOD;
    const int gw = bid * NWAVES + wave, NGW = G * NWAVES;
    for (int it = gw; it < NITEMS; it += NGW) {
        int r = it;
        if (r < I_IN) { p0_transpose_item(p.in[I_WIN], D, INW, (bf16_t*)(ws + WS_WIN), scr, r, lane); continue; } r -= I_IN;
        if (r < I_UP) { p0_transpose_item(p.in[I_WUP], D, UPW, (bf16_t*)(ws + WS_WUP), scr, r, lane); continue; } r -= I_UP;
        if (r < I_DN) { p0_transpose_item(p.in[I_WDN], DFF, D, (bf16_t*)(ws + WS_WDN), scr, r, lane); continue; } r -= I_DN;
        if (r < I_BR) { p0_transpose_item(p.in[I_WBR], D, D, (bf16_t*)(ws + WS_WBR), scr, r, lane); continue; } r -= I_BR;
        if (r < I_BP) { p0_transpose_item(p.in[I_WBP], 512, D, (bf16_t*)(ws + WS_WBP), scr, r, lane); continue; } r -= I_BP;
        if (r < I_OUT) { p0_transpose_item(p.in[I_WOUT], D, D, (bf16_t*)(ws + WS_WOUT), scr, r, lane); continue; } r -= I_OUT;
        if (r < 4 * I_PW1) { const int gi = r / I_PW1; p0_transpose_item(p.in[I_POOLW] + (size_t)gi * 128 * 128, 128, 128, (bf16_t*)(ws + WS_PW) + (size_t)gi * 128 * 128, scr, r % I_PW1, lane); continue; } r -= 4 * I_PW1;
        {
            const int jg = r / KSPLIT, ks = r % KSPLIT, j = 64 * jg + lane, kb = 128 * ks;
            const float* wa = p.in[I_WADA] + (size_t)kb * NMOD + j;
            float a0 = 0.f, a1 = 0.f, a2 = 0.f;
#pragma unroll
            for (int hh = 0; hh < 2; ++hh) {
                const int k = kb + 64 * hh + lane;
                const float s0 = siluf_(p.in[I_C][k]), s1 = siluf_(p.in[I_C][D + k]), s2 = siluf_(p.in[I_CCTX][k]);
#pragma unroll 16
                for (int kk = 0; kk < 64; ++kk) {
                    const float w = wa[(size_t)(64 * hh + kk) * NMOD];
                    a0 += __shfl(s0, kk) * w; a1 += __shfl(s1, kk) * w; a2 += __shfl(s2, kk) * w;
                }
            }
            float* part = (float*)(ws + WS_MODP) + (size_t)ks * 3 * NMOD + j;
            part[0] = a0; part[NMOD] = a1; part[2 * NMOD] = a2;
        }
    }
}

__device__ __forceinline__ void row_stats(const f32x4 (&v)[4], float& mean, float& rstd) {
    float s = 0.f;
#pragma unroll
    for (int j = 0; j < 4; ++j) s += (v[j].x + v[j].y) + (v[j].z + v[j].w);
    mean = wave_sum(s) * (1.f / D); float s2 = 0.f;
#pragma unroll
    for (int j = 0; j < 4; ++j) { const f32x4 d = v[j] - mean; s2 += (d.x * d.x + d.y * d.y) + (d.z * d.z + d.w * d.w); }
    rstd = 1.f / sqrtf(wave_sum(s2) * (1.f / D) + LN_EPS);
}
__device__ __forceinline__ void phase_mod1(const Params& p, LAS unsigned char* L, int G, int bid, int tid, int wave, int lane) {
    unsigned char* ws = p.ws;
    const float* part = (const float*)(ws + WS_MODP); const float* bada = p.in[I_BADA];
    LAS float* T = (LAS float*)L;
    for (int idx = tid; idx < 3 * 2048; idx += NTHR) { const int v = idx / 2048, j = idx % 2048; float s = bada[j];
#pragma unroll
        for (int ks = 0; ks < KSPLIT; ++ks) s += part[((size_t)ks * 3 + v) * NMOD + j];
        T[idx] = s; }
    float* MOD = (float*)(ws + WS_MOD);
    for (int idx = bid * NTHR + tid; idx < 3 * NMOD; idx += G * NTHR) { const int v = idx / NMOD, j = idx % NMOD; float s = bada[j];
#pragma unroll
        for (int ks = 0; ks < KSPLIT; ++ks) s += part[((size_t)ks * 3 + v) * NMOD + j];
        MOD[idx] = s; }
    __syncthreads();
    const int gw = bid * NWAVES + wave, NGW = G * NWAVES;
    for (int m = gw; m < MTOK + MCTX; m += NGW) {
        const int v = m < SEQ ? 0 : (m < MTOK ? 1 : 2);
        const float* xr = m < MTOK ? p.in[I_X] + (size_t)m * D : p.in[I_CTX] + (size_t)(m - MTOK) * D;
        bf16_t* orow = m < MTOK ? (bf16_t*)(ws + WS_U) + (size_t)m * D : (bf16_t*)(ws + WS_UC) + (size_t)(m - MTOK) * D;
        f32x4 x[4];
#pragma unroll
        for (int j = 0; j < 4; ++j) x[j] = *((const f32x4*)xr + lane + 64 * j);
        float mean, rstd; row_stats(x, mean, rstd);
#pragma unroll
        for (int j = 0; j < 4; ++j) { const int col = 256 * j + 4 * lane;
            const f32x4 sh = *(const LAS f32x4*)(T + v * 2048 + col), sc = *(const LAS f32x4*)(T + v * 2048 + 1024 + col);
            const f32x4 o = (x[j] - mean) * rstd * (sc + 1.0f) + sh;
            u32x2 w; w.x = cvt_pk_bf16(o.x, o.y); w.y = cvt_pk_bf16(o.z, o.w);
            *((u32x2*)orow + lane + 64 * j) = w; }
    }
    __syncthreads();
}

__device__ __forceinline__ int ti_off(int row, int j) { return row * 272 + ((((j >> 2) ^ ((row >> 3) & 15))) << 3) + (j & 3) * 2; }
__device__ __forceinline__ int ti_blk(int row, int blk) { return row * 272 + ((blk ^ ((row >> 3) & 15)) << 3); }
__device__ __forceinline__ float log2_gamma(const float* logit, int dir, int h) {
    const float x = logit[dir * HEADS + h];
    return -log1pf(expf(-x)) * 1.4426950408889634f;
}
__device__ __forceinline__ void stage_vt(const bf16_t* src, int ld, LAS unsigned char* VT, int tid) {
#pragma unroll
    for (int it = 0; it < 4; ++it) { const int q = tid + NTHR * it, j = q >> 4, c = q & 15;
        const u32x4 w = *(const u32x4*)(src + (size_t)j * ld + 8 * c);
        const unsigned ww[4] = {w.x, w.y, w.z, w.w};
#pragma unroll
        for (int i = 0; i < 4; ++i) {
            *(LAS unsigned short*)(VT + ti_off(8 * c + 2 * i, j)) = (unsigned short)(ww[i] & 0xffffu);
            *(LAS unsigned short*)(VT + ti_off(8 * c + 2 * i + 1, j)) = (unsigned short)(ww[i] >> 16); } }
}

__device__ __forceinline__ void phase_kvsum(const Params& p, LAS unsigned char* L, int G, int bid, int tid, int wave, int lane) {
    unsigned char* ws = p.ws;
    LAS unsigned char* VT = L; LAS unsigned char* KTf = L + 34816; LAS unsigned char* KTb = L + 34816 + 17408;
    for (int un = bid; un < BATCH * HEADS * (NCH + 2); un += G) {
        asm volatile("" : "+v"(tid), "+v"(lane));
        const int r = lane & 15, g = lane >> 4;
        const int n = un % (NCH + 2), bh = un / (NCH + 2), h = bh % HEADS, b = bh / HEADS;
        const bf16_t* src; int ld; bf16_t *of, *ob;
        if (n < NCH) { src = (const bf16_t*)(ws + WS_PROJ) + (size_t)(b * SEQ + n * 128) * INW; ld = INW;
            of = (bf16_t*)(ws + WS_KVF) + ((size_t)bh * NCH + n) * 8192; ob = (bf16_t*)(ws + WS_KVB) + ((size_t)bh * NCH + n) * 8192; }
        else { const int ci = n - NCH; src = (const bf16_t*)(ws + WS_PROJC) + (size_t)(b * CTXL + ci * 128) * KVC; ld = KVC;
            of = (bf16_t*)(ws + WS_CKV) + (((size_t)bh * 2 + ci) * 2 + 0) * 8192; ob = of + 8192; }
        const float lgf = log2_gamma(p.in[I_DECAY], 0, h), lgb = log2_gamma(p.in[I_DECAY], 1, h);
        stage_vt(src + C_V + 128 * h, ld, VT, tid);
#pragma unroll
        for (int it = 0; it < 2; ++it) { const int q = tid + NTHR * it, j = q >> 3, c = q & 7;
            const u32x4 w = *(const u32x4*)(src + (size_t)j * ld + C_K + 64 * h + 8 * c);
            const float wf = exp2f(lgf * (float)(127 - j)) * 0.125f, wb = exp2f(lgb * (float)j) * 0.125f;
            const unsigned ww[4] = {w.x, w.y, w.z, w.w};
#pragma unroll
            for (int i = 0; i < 4; ++i) { const float lo = bflo(ww[i]), hi = bfhi(ww[i]);
                *(LAS unsigned short*)(KTf + ti_off(8 * c + 2 * i, j)) = (unsigned short)f2bf(lo * wf);
                *(LAS unsigned short*)(KTf + ti_off(8 * c + 2 * i + 1, j)) = (unsigned short)f2bf(hi * wf);
                *(LAS unsigned short*)(KTb + ti_off(8 * c + 2 * i, j)) = (unsigned short)f2bf(lo * wb);
                *(LAS unsigned short*)(KTb + ti_off(8 * c + 2 * i + 1, j)) = (unsigned short)f2bf(hi * wb); } }
        __syncthreads();
        f32x4 aF[4], aB[4];
#pragma unroll
        for (int t = 0; t < 4; ++t) { aF[t] = (f32x4){0.f, 0.f, 0.f, 0.f}; aB[t] = (f32x4){0.f, 0.f, 0.f, 0.f}; }
        const int e = 16 * wave + r;
#pragma unroll
        for (int u = 0; u < 4; ++u) {
            const bf16x8 bv = mk8(*(const LAS u32x2*)(VT + ti_blk(e, 8 * u + g)), *(const LAS u32x2*)(VT + ti_blk(e, 8 * u + 4 + g)));
#pragma unroll
            for (int t = 0; t < 4; ++t) { const int d = 16 * t + r;
                const bf16x8 af = mk8(*(const LAS u32x2*)(KTf + ti_blk(d, 8 * u + g)), *(const LAS u32x2*)(KTf + ti_blk(d, 8 * u + 4 + g)));
                const bf16x8 ab = mk8(*(const LAS u32x2*)(KTb + ti_blk(d, 8 * u + g)), *(const LAS u32x2*)(KTb + ti_blk(d, 8 * u + 4 + g)));
                aF[t] = MFMA16(af, bv, aF[t]); aB[t] = MFMA16(ab, bv, aB[t]); }
        }
#pragma unroll
        for (int t = 0; t < 4; ++t) { u32x2 w; w.x = cvt_pk_bf16(aF[t][0], aF[t][1]); w.y = cvt_pk_bf16(aF[t][2], aF[t][3]);
            *(u32x2*)(of + (size_t)e * 64 + 16 * t + 4 * g) = w;
            w.x = cvt_pk_bf16(aB[t][0], aB[t][1]); w.y = cvt_pk_bf16(aB[t][2], aB[t][3]);
            *(u32x2*)(ob + (size_t)e * 64 + 16 * t + 4 * g) = w; }
        __syncthreads();
    }
}

__device__ __forceinline__ void phase_scan(const Params& p, int G, int bid, int tid) {
    unsigned char* ws = p.ws;
    for (int item = bid * NTHR + tid; item < 2 * 65536; item += G * NTHR) {
        const int dir = item >> 16, rem = item & 65535, bh = rem >> 12, pi = rem & 4095, h = bh % HEADS;
        const float dec = exp2f(128.0f * log2_gamma(p.in[I_DECAY], dir, h));
        const bf16_t* ck = (const bf16_t*)(ws + WS_CKV);
        const unsigned c0 = *(const unsigned*)(ck + (((size_t)bh * 2 + 0) * 2 + dir) * 8192 + 2 * pi), c1 = *(const unsigned*)(ck + (((size_t)bh * 2 + 1) * 2 + dir) * 8192 + 2 * pi);
        float s0, s1;
        if (dir == 0) { s0 = dec * bflo(c0) + bflo(c1); s1 = dec * bfhi(c0) + bfhi(c1); }
        else          { s0 = bflo(c0) + dec * bflo(c1); s1 = bfhi(c0) + dec * bfhi(c1); }
        unsigned* base = (unsigned*)((bf16_t*)(ws + (dir == 0 ? WS_KVF : WS_KVB)) + (size_t)bh * NCH * 8192 + 2 * pi);
        for (int n0 = 0; n0 < NCH; n0 += 8) {
            unsigned t[8];
#pragma unroll
            for (int i = 0; i < 8; ++i) { const int n = dir == 0 ? n0 + i : NCH - 1 - (n0 + i); t[i] = base[(size_t)n * 4096]; }
#pragma unroll
            for (int i = 0; i < 8; ++i) { const int n = dir == 0 ? n0 + i : NCH - 1 - (n0 + i);
                base[(size_t)n * 4096] = cvt_pk_bf16(s0, s1);
                s0 = dec * s0 + bflo(t[i]); s1 = dec * s1 + bfhi(t[i]); }
        }
    }
}

__device__ __forceinline__ void ret_unit(const Params& p, LAS unsigned char* L, int un, int tid, int wave, int lane) {
    asm volatile("" : "+v"(tid), "+v"(lane));
    unsigned char* ws = p.ws;
    LAS unsigned char* Qs = L; LAS unsigned char* Ks = L + 18432; LAS unsigned char* VT = L + 36864; LAS unsigned char* SF = L + 71680; LAS unsigned char* SB = L + 90112;
    const int n = un % NCH, bh = un / NCH, h = bh % HEADS, b = bh / HEADS;
    bf16_t* proj = (bf16_t*)(ws + WS_PROJ) + (size_t)(b * SEQ + n * 128) * INW;
    const bf16_t* sf = (const bf16_t*)(ws + WS_KVF) + ((size_t)bh * NCH + n) * 8192; const bf16_t* sb = (const bf16_t*)(ws + WS_KVB) + ((size_t)bh * NCH + n) * 8192;
    const float lgf = log2_gamma(p.in[I_DECAY], 0, h), lgb = log2_gamma(p.in[I_DECAY], 1, h);
    stage_vt(proj + C_V + 128 * h, INW, VT, tid);
#pragma unroll
    for (int it = 0; it < 2; ++it) { const int q = tid + NTHR * it, j = q >> 3, c = q & 7;
        *(LAS u32x4*)(Qs + j * 144 + c * 16) = *(const u32x4*)(proj + (size_t)j * INW + C_Q + 64 * h + 8 * c);
        *(LAS u32x4*)(Ks + j * 144 + c * 16) = *(const u32x4*)(proj + (size_t)j * INW + C_K + 64 * h + 8 * c);
        *(LAS u32x4*)(SF + j * 144 + c * 16) = *(const u32x4*)(sf + (size_t)q * 8);
        *(LAS u32x4*)(SB + j * 144 + c * 16) = *(const u32x4*)(sb + (size_t)q * 8); }
    __syncthreads();
    const int r = lane & 15, g = lane >> 4, il = 16 * wave + r;
    bf16x8 qf[2];
#pragma unroll
    for (int u = 0; u < 2; ++u) qf[u] = *(const LAS bf16x8*)(Qs + il * 144 + (32 * u + 8 * g) * 2);
    bf16x8 pf[4];
    {
        f32x4 aS[8];
#pragma unroll
        for (int t = 0; t < 8; ++t) { aS[t] = (f32x4){0.f, 0.f, 0.f, 0.f};
#pragma unroll
            for (int u = 0; u < 2; ++u) { const bf16x8 kf = *(const LAS bf16x8*)(Ks + (16 * t + r) * 144 + (32 * u + 8 * g) * 2); aS[t] = MFMA16(kf, qf[u], aS[t]); }
            if (t & 1) __builtin_amdgcn_sched_barrier(0); }
        unsigned pk[8][2];
#pragma unroll
        for (int t = 0; t < 8; ++t) { float pv[4];
#pragma unroll
            for (int i4 = 0; i4 < 4; ++i4) { const int j = 16 * t + 4 * g + i4, dl = il - j;
                const float dc = dl > 0 ? exp2f(lgf * (float)dl) : (dl < 0 ? exp2f(lgb * (float)(-dl)) : 2.0f);
                pv[i4] = aS[t][i4] * 0.125f * dc; }
            pk[t][0] = cvt_pk_bf16(pv[0], pv[1]); pk[t][1] = cvt_pk_bf16(pv[2], pv[3]); }
#pragma unroll
        for (int u = 0; u < 4; ++u) { u32x4 w = {pk[2 * u][0], pk[2 * u][1], pk[2 * u + 1][0], pk[2 * u + 1][1]}; pf[u] = __builtin_bit_cast(bf16x8, w); }
    }
    const float qdf = exp2f(lgf * (float)(il + 1)), qdb = exp2f(lgb * (float)(128 - il));
    bf16x8 qF[2], qB[2];
#pragma unroll
    for (int u = 0; u < 2; ++u) { const u32x4 w = __builtin_bit_cast(u32x4, qf[u]); u32x4 a, c;
        a.x = cvt_pk_bf16(bflo(w.x) * qdf, bfhi(w.x) * qdf); a.y = cvt_pk_bf16(bflo(w.y) * qdf, bfhi(w.y) * qdf); a.z = cvt_pk_bf16(bflo(w.z) * qdf, bfhi(w.z) * qdf); a.w = cvt_pk_bf16(bflo(w.w) * qdf, bfhi(w.w) * qdf);
        c.x = cvt_pk_bf16(bflo(w.x) * qdb, bfhi(w.x) * qdb); c.y = cvt_pk_bf16(bflo(w.y) * qdb, bfhi(w.y) * qdb); c.z = cvt_pk_bf16(bflo(w.z) * qdb, bfhi(w.z) * qdb); c.w = cvt_pk_bf16(bflo(w.w) * qdb, bfhi(w.w) * qdb);
        qF[u] = __builtin_bit_cast(bf16x8, a); qB[u] = __builtin_bit_cast(bf16x8, c); }
    f32x4 aO[8];
    float s = 0.f;
#pragma unroll
    for (int te = 0; te < 8; ++te) { aO[te] = (f32x4){0.f, 0.f, 0.f, 0.f};
        const int e = 16 * te + r;
#pragma unroll
        for (int u = 0; u < 4; ++u) { const bf16x8 vf = mk8(*(const LAS u32x2*)(VT + ti_blk(e, 8 * u + g)), *(const LAS u32x2*)(VT + ti_blk(e, 8 * u + 4 + g))); aO[te] = MFMA16(vf, pf[u], aO[te]); }
#pragma unroll
        for (int u = 0; u < 2; ++u) { const bf16x8 s1 = *(const LAS bf16x8*)(SF + e * 144 + (32 * u + 8 * g) * 2), s2 = *(const LAS bf16x8*)(SB + e * 144 + (32 * u + 8 * g) * 2);
            aO[te] = MFMA16(s1, qF[u], aO[te]); aO[te] = MFMA16(s2, qB[u], aO[te]); }
        s += (aO[te][0] + aO[te][1]) + (aO[te][2] + aO[te][3]);
        __builtin_amdgcn_sched_barrier(0); }
    s += __shfl_xor(s, 16); s += __shfl_xor(s, 32);
    const float mean = s * (1.0f / 128.0f); float q2 = 0.f;
#pragma unroll
    for (int te = 0; te < 8; ++te) { const f32x4 d = aO[te] - mean; q2 += (d[0] * d[0] + d[1] * d[1]) + (d[2] * d[2] + d[3] * d[3]); }
    q2 += __shfl_xor(q2, 16); q2 += __shfl_xor(q2, 32);
    const float rstd = 1.0f / sqrtf(q2 * (1.0f / 128.0f) + LN_EPS);
    bf16_t* grow = proj + (size_t)il * INW + C_G + 128 * h + 4 * g;
#pragma unroll
    for (int te = 0; te < 8; ++te) { const u32x2 gw = *(const u32x2*)(grow + 16 * te);
        const float g0 = bflo(gw.x), g1 = bfhi(gw.x), g2 = bflo(gw.y), g3 = bfhi(gw.y);
        const f32x4 y = (aO[te] - mean) * rstd;
        u32x2 w; w.x = cvt_pk_bf16(y[0] * siluf_(g0), y[1] * siluf_(g1)); w.y = cvt_pk_bf16(y[2] * siluf_(g2), y[3] * siluf_(g3));
        *(u32x2*)(grow + 16 * te) = w; }
    __syncthreads();
}

__device__ __forceinline__ void pool_unit(const Params& p, LAS unsigned char* L, int un, int tid, int wave, int lane) {
    asm volatile("" : "+v"(tid), "+v"(lane));
    unsigned char* ws = p.ws;
    LAS unsigned char* Ps = L; LAS unsigned char* Ds = L + 39168; LAS unsigned char* Wt = L + 73984;
    const int gi = un & 3, tt = un >> 2, b = tt / NCH, t0 = (tt % NCH) * 128, hw = 1 << gi;
    const bf16_t* proj = (const bf16_t*)(ws + WS_PROJ) + (size_t)(b * SEQ) * INW + C_P + 128 * gi;
    for (int q = tid; q < 144 * 16; q += NTHR) { const int rr = q >> 4, c = q & 15, t = t0 - 8 + rr;
        u32x4 w = {0u, 0u, 0u, 0u};
        if (t >= 0 && t < SEQ) w = *(const u32x4*)(proj + (size_t)t * INW + 8 * c);
        *(LAS u32x4*)(Ps + rr * 272 + c * 16) = w; }
    const bf16_t* pw = (const bf16_t*)(ws + WS_PW) + (size_t)gi * 128 * 128;
#pragma unroll
    for (int it = 0; it < 4; ++it) { const int q = tid + NTHR * it, rr = q >> 4, c = q & 15;
        *(LAS u32x4*)(Wt + rr * 272 + c * 16) = *(const u32x4*)(pw + (size_t)q * 8); }
    __syncthreads();
#pragma unroll
    for (int it = 0; it < 4; ++it) { const int q = tid + NTHR * it, i = q >> 4, c = q & 15, t = t0 + i;
        float a[8];
#pragma unroll
        for (int k = 0; k < 8; ++k) a[k] = 0.f;
        int cnt = 0;
        for (int kk = 0; kk < 2 * hw; ++kk) { const int t2 = t - hw + kk;
            if (t2 >= 0 && t2 < SEQ) { const u32x4 w = *(const LAS u32x4*)(Ps + (t2 - t0 + 8) * 272 + c * 16); ++cnt;
                a[0] += bflo(w.x); a[1] += bfhi(w.x); a[2] += bflo(w.y); a[3] += bfhi(w.y); a[4] += bflo(w.z); a[5] += bfhi(w.z); a[6] += bflo(w.w); a[7] += bfhi(w.w); } }
        const u32x4 cw = *(const LAS u32x4*)(Ps + (i + 8) * 272 + c * 16);
        const float inv = 1.0f / (float)cnt;
        u32x4 o; o.x = cvt_pk_bf16(a[0] * inv - bflo(cw.x), a[1] * inv - bfhi(cw.x)); o.y = cvt_pk_bf16(a[2] * inv - bflo(cw.y), a[3] * inv - bfhi(cw.y));
        o.z = cvt_pk_bf16(a[4] * inv - bflo(cw.z), a[5] * inv - bfhi(cw.z)); o.w = cvt_pk_bf16(a[6] * inv - bflo(cw.w), a[7] * inv - bfhi(cw.w));
        *(LAS u32x4*)(Ds + i * 272 + c * 16) = o; }
    __syncthreads();
    const int r = lane & 15, g = lane >> 4, il = 16 * wave + r;
    bf16x8 df[4];
#pragma unroll
    for (int u = 0; u < 4; ++u) df[u] = *(const LAS bf16x8*)(Ds + il * 272 + (32 * u + 8 * g) * 2);
    bf16_t* orow = (bf16_t*)(ws + WS_POOL) + (size_t)(b * SEQ + t0 + il) * 512 + 128 * gi + 4 * g;
    const float* psc = p.in[I_POOLS] + 128 * gi + 4 * g;
#pragma unroll
    for (int tn = 0; tn < 8; ++tn) { f32x4 acc = {0.f, 0.f, 0.f, 0.f};
#pragma unroll
        for (int u = 0; u < 4; ++u) { const bf16x8 wf = *(const LAS bf16x8*)(Wt + (16 * tn + r) * 272 + (32 * u + 8 * g) * 2); acc = MFMA16(wf, df[u], acc); }
        const f32x4 sc = *(const f32x4*)(psc + 16 * tn);
        u32x2 w; w.x = cvt_pk_bf16(acc[0] * sc[0], acc[1] * sc[1]); w.y = cvt_pk_bf16(acc[2] * sc[2], acc[3] * sc[3]);
        *(u32x2*)(orow + 16 * tn) = w; }
    __syncthreads();
}

template <bool WITH_MOD> __device__ __forceinline__ void phase_postnorm(const Params& p, float* io, const float* gam, const float* bet, int G, int bid, int wave, int lane) {
    const int gw = bid * NWAVES + wave, NGW = G * NWAVES;
    const float* MOD = (const float*)(p.ws + WS_MOD);
    for (int m = gw; m < MTOK; m += NGW) {
        f32x4* row = (f32x4*)(io + (size_t)m * D);
        f32x4 x[4];
#pragma unroll
        for (int j = 0; j < 4; ++j) x[j] = row[lane + 64 * j];
        float mean, rstd; row_stats(x, mean, rstd);
#pragma unroll
        for (int j = 0; j < 4; ++j) { const f32x4 gg = *((const f32x4*)gam + lane + 64 * j), bb = *((const f32x4*)bet + lane + 64 * j);
            x[j] = (x[j] - mean) * rstd * gg + bb; row[lane + 64 * j] = x[j]; }
        if (WITH_MOD) {
            row_stats(x, mean, rstd);
            const float* mb = MOD + (size_t)(m / SEQ) * NMOD;
            bf16_t* orow = (bf16_t*)(p.ws + WS_U) + (size_t)m * D;
#pragma unroll
            for (int j = 0; j < 4; ++j) { const f32x4 sh = *((const f32x4*)(mb + 3 * D) + lane + 64 * j), sc = *((const f32x4*)(mb + 4 * D) + lane + 64 * j);
                const f32x4 o = (x[j] - mean) * rstd * (sc + 1.0f) + sh;
                u32x2 w; w.x = cvt_pk_bf16(o.x, o.y); w.y = cvt_pk_bf16(o.z, o.w);
                *((u32x2*)orow + lane + 64 * j) = w; }
        }
    }
}

__device__ __forceinline__ float gelu_tanh(float x) { const float u = 0.7978845608028654f * (x + 0.044715f * x * x * x); return x / (1.0f + __expf(-2.0f * u)); }
__device__ __forceinline__ void conv_pass(const bf16_t* Hb, int chan, const float* cw, const float* cb, int y, int x0, f32x4 (&res)[4]) {
    u32x2 v[3][6];
#pragma unroll
    for (int dy = 0; dy < 3; ++dy) { const int yy = y + dy - 1, yc = yy < 0 ? 0 : (yy > 127 ? 127 : yy);
#pragma unroll
        for (int cx = 0; cx < 6; ++cx) { const int xx = x0 - 1 + cx, xc = xx < 0 ? 0 : (xx > 63 ? 63 : xx);
            v[dy][cx] = *(const u32x2*)((const char*)Hb + (unsigned)(((yc * 64 + xc) * UPW + chan) * 2)); } }
    f32x4 w[9];
#pragma unroll
    for (int k = 0; k < 9; ++k) w[k] = *(const f32x4*)((const char*)cw + (unsigned)((k * UPW + chan) * 4));
    const f32x4 bias = *(const f32x4*)((const char*)cb + (unsigned)(chan * 4));
#pragma unroll
    for (int dy = 0; dy < 3; ++dy) { const int yy = y + dy - 1; const bool yok = (yy >= 0) && (yy < 128);
#pragma unroll
        for (int cx = 0; cx < 6; ++cx) { const int xx = x0 - 1 + cx; const bool ok = yok && (xx >= 0) && (xx < 64);
            v[dy][cx].x = ok ? v[dy][cx].x : 0u; v[dy][cx].y = ok ? v[dy][cx].y : 0u; } }
#pragma unroll
    for (int xi = 0; xi < 4; ++xi) { f32x4 a = bias;
#pragma unroll
        for (int dy = 0; dy < 3; ++dy)
#pragma unroll
            for (int dx = 0; dx < 3; ++dx) { const u32x2 t = v[dy][xi + dx]; const f32x4 ww = w[dy * 3 + dx];
                a[0] += bflo(t.x) * ww[0]; a[1] += bfhi(t.x) * ww[1]; a[2] += bflo(t.y) * ww[2]; a[3] += bfhi(t.y) * ww[3]; }
        res[xi] = a; }
}
__device__ __forceinline__ void phase_conv(const Params& p, int half, int G, int bid, int tid) {
    const bf16_t* Hh = (const bf16_t*)(p.ws + WS_H);
    bf16_t* HC = (bf16_t*)(p.ws + WS_HC) + (size_t)half * SEQ * DFF;
    const float* cw = p.in[I_CONVW]; const float* cb = p.in[I_CONVB];
    constexpr int NCK = DFF / 4, NITEM = 128 * 16 * NCK;
    for (int item = bid * NTHR + tid; item < NITEM; item += G * NTHR) {
        const int ck = item % NCK, xo = (item / NCK) & 15, y = item / (16 * NCK), ch = 4 * ck, x0 = 4 * xo;
        f32x4 ra[4], rb[4];
        conv_pass(Hh, ch, cw, cb, y, x0, ra);
#pragma unroll
        for (int xi = 0; xi < 4; ++xi) { ra[xi][0] = gelu_tanh(ra[xi][0]); ra[xi][1] = gelu_tanh(ra[xi][1]); ra[xi][2] = gelu_tanh(ra[xi][2]); ra[xi][3] = gelu_tanh(ra[xi][3]); }
        asm volatile("" ::: "memory"); __builtin_amdgcn_sched_barrier(0);
        conv_pass(Hh, DFF + ch, cw, cb, y, x0, rb);
#pragma unroll
        for (int xi = 0; xi < 4; ++xi) { u32x2 o; o.x = cvt_pk_bf16(ra[xi][0] * rb[xi][0], ra[xi][1] * rb[xi][1]); o.y = cvt_pk_bf16(ra[xi][2] * rb[xi][2], ra[xi][3] * rb[xi][3]);
            *(u32x2*)(HC + (size_t)(y * 64 + x0 + xi) * DFF + ch) = o; }
    }
}

#ifndef MK_COOP
#define MK_COOP 1
#endif
constexpr int NPHASE = 15;
__global__ void __launch_bounds__(NTHR, 2) hybrid_fwd(Params p) {
    extern __shared__ __attribute__((aligned(16))) unsigned char lds_raw[];
    LAS unsigned char* L = (LAS unsigned char*)lds_raw;
    const int tid = threadIdx.x, lane = tid & 63, wave = __builtin_amdgcn_readfirstlane(tid >> 6);
    const int G = gridDim.x, bid = blockIdx.x;
    unsigned char* ws = p.ws;
    const int lo = p.ph_lo, hi = p.ph_hi;
#define IN(k) (lo <= (k) && (k) < hi)
#define SEAM(k) do { if (IN(k) && IN((k) + 1)) { cg::this_grid().sync(); } } while (0)

    if (IN(0)) { phase_prep(p, L, G, bid, wave, lane); } SEAM(0);
    if (IN(1)) { phase_mod1(p, L, G, bid, tid, wave, lane); } SEAM(1);
    if (IN(2)) {
        { pg8::Gemm g{(const bf16_t*)(ws + WS_U), (const bf16_t*)(ws + WS_WIN), D, MTOK, INW, D}; pg8::StaticOrder S; S.init(MTOK, INW, G, bid);
          EpiStoreBf16 E{(bf16_t*)(ws + WS_PROJ), INW}; pg8::gemm_phase<EpiStoreBf16, pg8::StaticOrder, true, true>(L, g, S, E); }
        { pg8::Gemm g{(const bf16_t*)(ws + WS_UC), (const bf16_t*)(ws + WS_WIN), D, MCTX, KVC, D}; pg8::StaticOrder S; S.init(MCTX, KVC, G, G - 1 - bid);
          EpiStoreBf16 E{(bf16_t*)(ws + WS_PROJC), KVC}; pg8::gemm_phase<EpiStoreBf16, pg8::StaticOrder, true, true>(L, g, S, E); }
    } SEAM(2);
    if (IN(3)) { phase_kvsum(p, L, G, bid, tid, wave, lane); } SEAM(3);
    if (IN(4)) { phase_scan(p, G, bid, tid); } SEAM(4);
    if (IN(5)) {
        for (int un = bid; un < BATCH * HEADS * NCH; un += G) ret_unit(p, L, un, tid, wave, lane);
        for (int un = bid; un < (MTOK / 128) * 4; un += G) pool_unit(p, L, un, tid, wave, lane);
    } SEAM(5);
    if (IN(6)) {
        bf16_t* proj = (bf16_t*)(ws + WS_PROJ);
        { pg8::Gemm g{proj + C_G, (const bf16_t*)(ws + WS_WBR), INW, MTOK, D, D}; pg8::StaticOrder S; S.init(MTOK, D, G, bid);
          EpiGate<0> E{proj + C_GA, proj + C_GB, INW}; pg8::gemm_phase<EpiGate<0>, pg8::StaticOrder, true, true>(L, g, S, E); }
        { pg8::Gemm g{(const bf16_t*)(ws + WS_POOL), (const bf16_t*)(ws + WS_WBP), 512, MTOK, D, 512}; pg8::StaticOrder S; S.init(MTOK, D, G, bid);
          EpiGate<1> E{proj + C_GA, proj + C_GB, INW}; pg8::gemm_phase<EpiGate<1>, pg8::StaticOrder, true, true>(L, g, S, E); }
    } SEAM(6);
    if (IN(7)) {
        pg8::Gemm g{(const bf16_t*)(ws + WS_PROJ) + C_GA, (const bf16_t*)(ws + WS_WOUT), INW, MTOK, D, D}; pg8::StaticOrder S; S.init(MTOK, D, G, bid);
        EpiResid E{p.in[I_X], p.out, (const float*)(ws + WS_MOD) + 2 * D}; pg8::gemm_phase<EpiResid, pg8::StaticOrder, true, true>(L, g, S, E);
    } SEAM(7);
    if (IN(8)) { phase_postnorm<true>(p, p.out, p.in[I_LN1G], p.in[I_LN1B], G, bid, wave, lane); } SEAM(8);
#pragma unroll 1
    for (int half = 0; half < 2; ++half) {
        if (IN(9 + 2 * half)) {
            pg8::Gemm g{(const bf16_t*)(ws + WS_U) + (size_t)half * SEQ * D, (const bf16_t*)(ws + WS_WUP), D, SEQ, UPW, D}; pg8::StaticOrder S; S.init(SEQ, UPW, G, bid);
            EpiStoreBf16 E{(bf16_t*)(ws + WS_H), UPW}; pg8::gemm_phase<EpiStoreBf16, pg8::StaticOrder, true, true>(L, g, S, E);
        } SEAM(9 + 2 * half);
        if (IN(10 + 2 * half)) { phase_conv(p, half, G, bid, tid); } SEAM(10 + 2 * half);
    }
    if (IN(13)) {
        pg8::Gemm g{(const bf16_t*)(ws + WS_HC), (const bf16_t*)(ws + WS_WDN), DFF, MTOK, D, DFF}; pg8::StaticOrder S; S.init(MTOK, D, G, bid);
        EpiResid E{p.out, p.out, (const float*)(ws + WS_MOD) + 5 * D}; pg8::gemm_phase<EpiResid, pg8::StaticOrder, true, true>(L, g, S, E);
    } SEAM(13);
    if (IN(14)) { phase_postnorm<false>(p, p.out, p.in[I_LN2G], p.in[I_LN2B], G, bid, wave, lane); }
#undef IN
#undef SEAM
}

extern "C" void kernel_launch(void* const* d_in, const int* in_sizes, int n_in, void* d_out, int out_size, void* d_ws, size_t ws_size, hipStream_t stream) {
    static int grid = 0;
    if (grid == 0) {
        if (n_in != 21 || in_sizes[0] != MTOK * D || out_size != MTOK * D || ws_size < WS_END) { fprintf(stderr, "kernel_launch: unexpected shapes (n_in %d, in0 %d, out %d, ws %zu); nothing launched\n", n_in, n_in > 0 ? in_sizes[0] : -1, out_size, ws_size); grid = -1; return; }
        int dev = 0, cus = 0, per_cu = 0;
        if (hipGetDevice(&dev) != hipSuccess || hipDeviceGetAttribute(&cus, hipDeviceAttributeMultiprocessorCount, dev) != hipSuccess) { grid = -1; return; }
        if (hipFuncSetAttribute((const void*)hybrid_fwd, hipFuncAttributeMaxDynamicSharedMemorySize, LDS_BYTES) != hipSuccess) { fprintf(stderr, "kernel_launch: hipFuncSetAttribute failed\n"); grid = -1; return; }
        if (hipOccupancyMaxActiveBlocksPerMultiprocessor(&per_cu, (const void*)hybrid_fwd, NTHR, LDS_BYTES) != hipSuccess || per_cu < 1) { fprintf(stderr, "kernel_launch: occupancy query says %d blocks per CU\n", per_cu); (void)hipGetLastError(); grid = -1; return; }
        grid = cus * per_cu; if (grid > 256) grid = 256;
    }
    if (grid < 0) return;
    Params a{};
    for (int i = 0; i < 21; ++i) a.in[i] = (const float*)d_in[i];
    a.out = (float*)d_out; a.ws = (unsigned char*)d_ws;
#if MK_COOP
    a.ph_lo = 0; a.ph_hi = NPHASE;
    void* args[] = {&a};
    hipError_t e = hipLaunchCooperativeKernel((const void*)hybrid_fwd, dim3(grid), dim3(NTHR), args, LDS_BYTES, stream);
    if (e != hipSuccess) fprintf(stderr, "kernel_launch: cooperative launch failed: %s (grid %d)\n", hipGetErrorString(e), grid);
#else
    for (int ph = 0; ph < NPHASE; ++ph) { a.ph_lo = ph; a.ph_hi = ph + 1; hipLaunchKernelGGL(hybrid_fwd, dim3(grid), dim3(NTHR), LDS_BYTES, stream, a); }
#endif
}
```

```cpp
#include <hip/hip_runtime.h>
#include <hip/hip_cooperative_groups.h>
#include <cstdio>
#include <cstdint>
namespace cg = cooperative_groups;
namespace pg8 {
#define PG8_LAS __attribute__((address_space(3)))
typedef unsigned short bf16_t;
typedef short bf16x8 __attribute__((ext_vector_type(8)));
typedef float f32x4 __attribute__((ext_vector_type(4)));
typedef unsigned u32x4 __attribute__((ext_vector_type(4)));
constexpr int BM = 256, BK = 64, HALF = 128, HTB = HALF * BK * 2  , STAGE_BYTES = 8 * HTB, NXCD = 8, WGM = 8;

__host__ __device__ __forceinline__ int lds_byte(int r, int c) { const int st = (r >> 4) * 2 + (c >> 5), rr = r & 15, cc = c & 31, ob = rr * 64 + cc * 2; return st * 1024 + (ob ^ (((ob >> 9) & 1) << 5)); }
__host__ __device__ __forceinline__ void stage_rc(int b, int& R, int& C) { const int st = b / 1024, sb = b % 1024, swz = sb ^ (((sb >> 9) & 1) << 5); R = (st >> 1) * 16 + swz / 64; C = (st & 1) * 32 + (swz % 64) / 2; }
__host__ __device__ __forceinline__ int perm32(int rho) { const int n = rho >> 4, i = rho & 15; return 8 * (i >> 2) + 4 * n + (i & 3); }

struct Unit { int pm, pn; };
struct Gemm { const bf16_t* A; const bf16_t* Bt; int lda, M, N, K; };

struct StaticOrder {
    int nM, nN, nwg, G, c;
    __host__ __device__ void init(int M, int N, int G_, int c_) { nM = M / BM; nN = N / BM; nwg = nM * nN; G = G_; c = c_; }
    __host__ __device__ bool next(int i, Unit& u) const {
        const long L = (long)i * G + c; if (L >= nwg) return false;
        int wgid = (int)L; { const int q = nwg / NXCD, r = nwg % NXCD, xcd = wgid % NXCD, off = wgid / NXCD; wgid = (xcd < r ? xcd * (q + 1) : r * (q + 1) + (xcd - r) * q) + off; }
        const int nig = WGM * nN, gid = wgid / nig, fm = gid * WGM, gsz = (nM - fm) < WGM ? (nM - fm) : WGM;
        u.pm = fm + ((wgid % nig) % gsz); u.pn = (wgid % nig) / gsz; return true;
    }
    __device__ __forceinline__ void a_ready(const Unit&) const {}
    __device__ __forceinline__ void done(const Unit&) const {}
};

__device__ __forceinline__ unsigned cvt_pk_bf16(float lo, float hi) { unsigned r; asm volatile("v_cvt_pk_bf16_f32 %0, %1, %2" : "=v"(r) : "v"(lo), "v"(hi)); return r; }
template <class Epi, class Sched, bool ALIGN_EPI = false, bool SP2 = false>
__device__ __forceinline__ void gemm_phase(PG8_LAS unsigned char* lds, const Gemm g, const Sched& S, const Epi& E) {
    int tid_ = threadIdx.x; asm volatile("" : "+v"(tid_));
    const int tid = tid_, wid = __builtin_amdgcn_readfirstlane(tid >> 6), lane = tid & 63, wr = wid >> 2, wc = wid & 3, fr = lane & 15, fq = lane >> 4;
    const int K = g.K, nt = K / BK;
    unsigned voffA[2], voffB[2];
#pragma unroll
    for (int i = 0; i < 2; ++i) { int R, C; stage_rc(tid * 16 + i * 8192, R, C); const int Rb = Epi::PERM ? ((R & ~31) + perm32(R & 31)) : R;
        voffA[i] = (unsigned)(R * g.lda + C) * 2u; voffB[i] = (unsigned)(Rb * K + C) * 2u; }
    const size_t kstep = (size_t)(BK * 2);
    const size_t hstep = (size_t)HALF * K * 2, hstepA = (size_t)HALF * g.lda * 2;
    const size_t tstep = 2 * hstep, tstepA = 2 * hstepA;
    const unsigned ldsw = (unsigned)wid * 1024u;
    const int aoff = lds_byte(wr * 64 + fr, fq * 8), boff = lds_byte(wc * 32 + fr, fq * 8);
#define PG8_SA(b, h) (((b) * 2 + (h)) * HTB)
#define PG8_SB(b, h) ((4 + (b) * 2 + (h)) * HTB)
#define PG8_STAGE(bufoff, gbase, voff) do { _Pragma("unroll") for (int _i = 0; _i < 2; ++_i) \
        __builtin_amdgcn_global_load_lds((const unsigned*)((const char*)(gbase) + (voff)[_i]), (PG8_LAS unsigned*)(lds + (bufoff) + ldsw + _i * 8192), 16, 0, 0); } while (0)
#define PG8_LDA(dst, b, h) do { _Pragma("unroll") for (int m = 0; m < 4; ++m) _Pragma("unroll") for (int k = 0; k < 2; ++k) dst[m][k] = *(const PG8_LAS bf16x8*)(lds + PG8_SA(b, h) + aoff + m * 2048 + k * 1024); } while (0)
#define PG8_LDB(dst, b, h) do { _Pragma("unroll") for (int n = 0; n < 2; ++n) _Pragma("unroll") for (int k = 0; k < 2; ++k) dst[n][k] = *(const PG8_LAS bf16x8*)(lds + PG8_SB(b, h) + boff + n * 2048 + k * 1024); } while (0)
#define PG8_MMA(ai, bj, At, Bt) do { __builtin_amdgcn_s_setprio(1); _Pragma("unroll") for (int m = 0; m < 4; ++m) _Pragma("unroll") for (int n = 0; n < 2; ++n) _Pragma("unroll") for (int k = 0; k < 2; ++k) \
        acc[ai][bj][m][n] = __builtin_amdgcn_mfma_f32_16x16x32_bf16(Bt[n][k], At[m][k], acc[ai][bj][m][n], 0, 0, 0); __builtin_amdgcn_s_setprio(0); } while (0)
#define PG8_WAIT_V(n) asm volatile("s_waitcnt vmcnt(" #n ")" ::: "memory")
#define PG8_WAIT_L(n) asm volatile("s_waitcnt lgkmcnt(" #n ")" ::: "memory")
#define PG8_BAR __builtin_amdgcn_s_barrier()
#define PG8_SCHED __builtin_amdgcn_sched_barrier(0)
    Unit cur, nxt; int ui = 0;
    if (!S.next(0, cur)) return;
    f32x4 acc[2][2][4][2];
#pragma unroll
    for (int a = 0; a < 2; ++a)
#pragma unroll
        for (int b = 0; b < 2; ++b)
#pragma unroll
            for (int m = 0; m < 4; ++m)
#pragma unroll
                for (int n = 0; n < 2; ++n) acc[a][b][m][n] = (f32x4){0.f, 0.f, 0.f, 0.f};
    bf16x8 At[4][2], B0[2][2], B1[2][2];
    const char* cA = (const char*)g.A + (size_t)cur.pm * tstepA; const char* cB = (const char*)g.Bt + (size_t)cur.pn * tstep;
    S.a_ready(cur);
    if constexpr (SP2) {
        PG8_STAGE(PG8_SB(0, 0), cB, voffB); PG8_STAGE(PG8_SB(0, 1), cB + hstep, voffB); PG8_STAGE(PG8_SA(0, 0), cA, voffA); PG8_STAGE(PG8_SA(0, 1), cA + hstepA, voffA);
        if (wr == 1) PG8_BAR;
        PG8_WAIT_V(2); PG8_BAR;
        PG8_STAGE(PG8_SB(1, 0), cB + kstep, voffB); PG8_STAGE(PG8_SA(1, 0), cA + kstep, voffA); PG8_STAGE(PG8_SB(1, 1), cB + hstep + kstep, voffB);
        PG8_WAIT_V(6); PG8_BAR;
    } else {
        PG8_STAGE(PG8_SB(0, 0), cB, voffB); PG8_STAGE(PG8_SA(0, 0), cA, voffA); PG8_STAGE(PG8_SB(0, 1), cB + hstep, voffB); PG8_STAGE(PG8_SA(0, 1), cA + hstepA, voffA);
        if (wr == 1) PG8_BAR;
        PG8_WAIT_V(4); PG8_BAR;
        PG8_STAGE(PG8_SB(1, 0), cB + kstep, voffB); PG8_STAGE(PG8_SA(1, 0), cA + kstep, voffA); PG8_STAGE(PG8_SB(1, 1), cB + hstep + kstep, voffB);
        PG8_WAIT_V(6); PG8_BAR;
    }
    for (;;) {
        const bool has_next = S.next(ui + 1, nxt);
        const char* nA = has_next ? (const char*)g.A + (size_t)nxt.pm * tstepA : cA; const char* nB = has_next ? (const char*)g.Bt + (size_t)nxt.pn * tstep : cB;
        for (int t = 0; t < nt; t += 2) {
            const bool last = (t == nt - 2);
            const char* a1 = cA + (size_t)(t + 1) * kstep;
            const char* a2 = last ? nA : cA + (size_t)(t + 2) * kstep; const char* b2 = last ? nB : cB + (size_t)(t + 2) * kstep;
            const char* a3 = a2 + kstep; const char* b3 = b2 + kstep;
            if (last && has_next) S.a_ready(nxt);
            if constexpr (SP2) {
            PG8_LDB(B0, 0, 0); PG8_LDB(B1, 0, 1); PG8_SCHED; PG8_LDA(At, 0, 0); PG8_STAGE(PG8_SA(1, 1), a1 + hstepA, voffA);
            PG8_WAIT_V(8); PG8_WAIT_L(0); PG8_BAR; PG8_MMA(0, 0, At, B0); PG8_MMA(0, 1, At, B1); PG8_BAR; PG8_SCHED;
            PG8_LDA(At, 0, 1); PG8_STAGE(PG8_SB(0, 0), b2, voffB); PG8_STAGE(PG8_SB(0, 1), b2 + hstep, voffB); PG8_STAGE(PG8_SA(0, 0), a2, voffA);
            PG8_WAIT_V(8); PG8_WAIT_L(0); PG8_BAR; PG8_MMA(1, 0, At, B0); PG8_MMA(1, 1, At, B1); PG8_BAR; PG8_SCHED;
            PG8_LDB(B0, 1, 0); PG8_LDB(B1, 1, 1); PG8_SCHED; PG8_LDA(At, 1, 0); PG8_STAGE(PG8_SA(0, 1), a2 + hstepA, voffA);
            PG8_WAIT_V(8); PG8_WAIT_L(0); PG8_BAR; PG8_MMA(0, 0, At, B0); PG8_MMA(0, 1, At, B1); PG8_BAR; PG8_SCHED;
            PG8_LDA(At, 1, 1); PG8_STAGE(PG8_SB(1, 0), b3, voffB); PG8_STAGE(PG8_SB(1, 1), b3 + hstep, voffB); PG8_STAGE(PG8_SA(1, 0), a3, voffA);
            PG8_WAIT_V(8); PG8_WAIT_L(0); PG8_BAR; PG8_MMA(1, 0, At, B0); PG8_MMA(1, 1, At, B1); PG8_BAR; PG8_SCHED;
            } else {
            PG8_LDB(B0, 0, 0); PG8_SCHED; PG8_LDA(At, 0, 0); PG8_STAGE(PG8_SA(1, 1), a1 + hstepA, voffA);
            PG8_WAIT_L(8); PG8_BAR; PG8_WAIT_L(0); PG8_MMA(0, 0, At, B0); PG8_BAR; PG8_SCHED;
            PG8_LDB(B1, 0, 1); PG8_STAGE(PG8_SB(0, 0), b2, voffB);
            PG8_BAR; PG8_WAIT_L(0); PG8_MMA(0, 1, At, B1); PG8_BAR;
            PG8_LDA(At, 0, 1); PG8_STAGE(PG8_SA(0, 0), a2, voffA);
            PG8_BAR; PG8_WAIT_L(0); PG8_MMA(1, 0, At, B0); PG8_BAR; PG8_SCHED;
            PG8_STAGE(PG8_SB(0, 1), b2 + hstep, voffB);
            PG8_WAIT_V(6); PG8_BAR; PG8_MMA(1, 1, At, B1); PG8_BAR;
            PG8_LDB(B0, 1, 0); PG8_SCHED; PG8_LDA(At, 1, 0); PG8_STAGE(PG8_SA(0, 1), a2 + hstepA, voffA);
            PG8_WAIT_L(8); PG8_BAR; PG8_WAIT_L(0); PG8_MMA(0, 0, At, B0); PG8_BAR; PG8_SCHED;
            PG8_LDB(B1, 1, 1); PG8_STAGE(PG8_SB(1, 0), b3, voffB);
            PG8_BAR; PG8_WAIT_L(0); PG8_MMA(0, 1, At, B1); PG8_BAR;
            PG8_LDA(At, 1, 1); PG8_STAGE(PG8_SA(1, 0), a3, voffA);
            PG8_BAR; PG8_WAIT_L(0); PG8_MMA(1, 0, At, B0); PG8_BAR; PG8_SCHED;
            PG8_STAGE(PG8_SB(1, 1), b3 + hstep, voffB);
            PG8_WAIT_V(6); PG8_BAR; PG8_MMA(1, 1, At, B1); PG8_BAR;
            }
        }
        if constexpr (ALIGN_EPI) { if (wr == 0) PG8_BAR; }
        if constexpr (!Epi::AFTER_DRAIN) { E(acc, cur, wr, wc, fr, fq); S.done(cur); }
        if (!has_next) break;
#pragma unroll
        for (int a = 0; a < 2; ++a)
#pragma unroll
            for (int b = 0; b < 2; ++b)
#pragma unroll
                for (int m = 0; m < 4; ++m)
#pragma unroll
                    for (int n = 0; n < 2; ++n) acc[a][b][m][n] = (f32x4){0.f, 0.f, 0.f, 0.f};
        cur = nxt; cA = nA; cB = nB; ++ui;
        if constexpr (ALIGN_EPI) { if (wr == 1) PG8_BAR; }
    }
    PG8_WAIT_V(0);
    if constexpr (!ALIGN_EPI) { if (wr == 0) PG8_BAR; }
    PG8_BAR;
    if constexpr (Epi::AFTER_DRAIN) { E.fused(acc, cur, wr, wc, fr, fq, lds, wid, lane); S.done(cur); }
#undef PG8_SA
#undef PG8_SB
#undef PG8_STAGE
#undef PG8_LDA
#undef PG8_LDB
#undef PG8_MMA
#undef PG8_WAIT_V
#undef PG8_WAIT_L
#undef PG8_BAR
#undef PG8_SCHED
}
}

#define LAS __attribute__((address_space(3)))
using pg8::bf16_t; using pg8::bf16x8; using pg8::f32x4; using pg8::u32x4; using pg8::cvt_pk_bf16;
typedef unsigned u32x2 __attribute__((ext_vector_type(2)));

constexpr int NTHR = 512, NWAVES = 8;
constexpr int D = 1024, SEQ = 8192, BATCH = 2, MTOK = BATCH * SEQ, CTXL = 256, MCTX = BATCH * CTXL;
constexpr int HEADS = 8, DK = 64, DV = 128, NCH = SEQ / 128;
constexpr int INW = 5632, KVC = 1536, DFF = 2816, UPW = 2 * DFF, NMOD = 6 * D;
constexpr int C_K = 0, C_V = 512, C_Q = 1536, C_G = 2048, C_P = 3072, C_GA = 3584, C_GB = 4608;
constexpr float LN_EPS = 1e-6f;
constexpr float DN_ALPHA = 1.18920711500272f;
constexpr int KSPLIT = 8;

constexpr size_t MiB = 1u << 20;
constexpr size_t WS_MODP = 64 * 1024, WS_MOD = 1 * MiB;
constexpr size_t WS_WUP = 2 * MiB, WS_WDN = 13 * MiB, WS_WBR = 19 * MiB, WS_WBP = 21 * MiB, WS_WOUT = 22 * MiB, WS_PW = 24 * MiB;
constexpr size_t WS_U = 25 * MiB, WS_KVF = 25 * MiB, WS_KVB = 41 * MiB;
constexpr size_t WS_UC = 57 * MiB, WS_PROJC = 58 * MiB, WS_CKV = 60 * MiB;
constexpr size_t WS_WIN = 61 * MiB, WS_POOL = 61 * MiB;
constexpr size_t WS_PROJ = 80 * MiB, WS_H = 80 * MiB, WS_HC = 168 * MiB, WS_END = 256 * MiB;
constexpr int LDS_BYTES = 147456;

struct Params { const float* in[21]; float* out; unsigned char* ws; int ph_lo, ph_hi; };
enum { I_X = 0, I_C, I_CTX, I_CCTX, I_WADA, I_BADA, I_WIN, I_DECAY, I_POOLW, I_POOLS, I_WBR, I_WBP, I_WOUT, I_LN1G, I_LN1B, I_WUP, I_CONVW, I_CONVB, I_WDN, I_LN2G, I_LN2B };

__device__ __forceinline__ unsigned f2bf(float f) { unsigned u = __builtin_bit_cast(unsigned, f); return (u + 0x7fffu + ((u >> 16) & 1u)) >> 16; }
__device__ __forceinline__ float bflo(unsigned w) { return __builtin_bit_cast(float, w << 16); }
__device__ __forceinline__ float bfhi(unsigned w) { return __builtin_bit_cast(float, w & 0xffff0000u); }
__device__ __forceinline__ float sigmoidf_(float x) { return 1.0f / (1.0f + __expf(-x)); }
__device__ __forceinline__ float wave_sum(float v) {
#pragma unroll
    for (int o = 1; o < 64; o <<= 1) v += __shfl_xor(v, o);
    return v;
}
#define LDS_WAIT() asm volatile("s_waitcnt lgkmcnt(0)" ::: "memory")
__device__ __forceinline__ bf16x8 mk8(u32x2 lo, u32x2 hi) { u32x4 w = {lo.x, lo.y, hi.x, hi.y}; return __builtin_bit_cast(bf16x8, w); }
#define MFMA16(a, b, c) __builtin_amdgcn_mfma_f32_16x16x32_bf16((a), (b), (c), 0, 0, 0)

struct EpiStoreBf16 {
    static constexpr bool PERM = true, AFTER_DRAIN = false;
    bf16_t* O; int ldc;
    __device__ __forceinline__ void operator()(const f32x4 (&acc)[2][2][4][2], const pg8::Unit& u, int wr, int wc, int fr, int fq) const {
        const int row0 = u.pm * 256 + wr * 64 + fr, col0 = u.pn * 256 + wc * 32 + 8 * fq;
#pragma unroll
        for (int ai = 0; ai < 2; ++ai)
#pragma unroll
            for (int m = 0; m < 4; ++m) { bf16_t* rowp = O + (size_t)(row0 + ai * 128 + m * 16) * ldc + col0;
#pragma unroll
                for (int bj = 0; bj < 2; ++bj) { const f32x4 v0 = acc[ai][bj][m][0], v1 = acc[ai][bj][m][1];
                    u32x4 w; w.x = cvt_pk_bf16(v0[0], v0[1]); w.y = cvt_pk_bf16(v0[2], v0[3]); w.z = cvt_pk_bf16(v1[0], v1[1]); w.w = cvt_pk_bf16(v1[2], v1[3]);
                    *(u32x4*)(rowp + bj * 128) = w; } }
    }
};
template <int MODE> struct EpiGate {
    static constexpr bool PERM = true, AFTER_DRAIN = false;
    bf16_t* Mg; const bf16_t* Gb; int ldc;
    __device__ __forceinline__ void operator()(const f32x4 (&acc)[2][2][4][2], const pg8::Unit& u, int wr, int wc, int fr, int fq) const {
        const int row0 = u.pm * 256 + wr * 64 + fr, col0 = u.pn * 256 + wc * 32 + 8 * fq;
#pragma unroll
        for (int ai = 0; ai < 2; ++ai)
#pragma unroll
            for (int m = 0; m < 4; ++m) { const size_t off = (size_t)(row0 + ai * 128 + m * 16) * ldc + col0;
#pragma unroll
                for (int bj = 0; bj < 2; ++bj) { const f32x4 v0 = acc[ai][bj][m][0], v1 = acc[ai][bj][m][1];
                    const u32x4 mg = *(const u32x4*)(Mg + off + bj * 128);
                    float r[8];
                    if (MODE == 0) {
                        r[0] = sigmoidf_(bflo(mg.x)) * v0[0]; r[1] = sigmoidf_(bfhi(mg.x)) * v0[1]; r[2] = sigmoidf_(bflo(mg.y)) * v0[2]; r[3] = sigmoidf_(bfhi(mg.y)) * v0[3];
                        r[4] = sigmoidf_(bflo(mg.z)) * v1[0]; r[5] = sigmoidf_(bfhi(mg.z)) * v1[1]; r[6] = sigmoidf_(bflo(mg.w)) * v1[2]; r[7] = sigmoidf_(bfhi(mg.w)) * v1[3];
                    } else {
                        const u32x4 gb = *(const u32x4*)(Gb + off + bj * 128);
                        r[0] = bflo(mg.x) + sigmoidf_(bflo(gb.x)) * v0[0]; r[1] = bfhi(mg.x) + sigmoidf_(bfhi(gb.x)) * v0[1]; r[2] = bflo(mg.y) + sigmoidf_(bflo(gb.y)) * v0[2]; r[3] = bfhi(mg.y) + sigmoidf_(bfhi(gb.y)) * v0[3];
                        r[4] = bflo(mg.z) + sigmoidf_(bflo(gb.z)) * v1[0]; r[5] = bfhi(mg.z) + sigmoidf_(bfhi(gb.z)) * v1[1]; r[6] = bflo(mg.w) + sigmoidf_(bflo(gb.w)) * v1[2]; r[7] = bfhi(mg.w) + sigmoidf_(bfhi(gb.w)) * v1[3];
                    }
                    u32x4 w; w.x = cvt_pk_bf16(r[0], r[1]); w.y = cvt_pk_bf16(r[2], r[3]); w.z = cvt_pk_bf16(r[4], r[5]); w.w = cvt_pk_bf16(r[6], r[7]);
                    *(u32x4*)(Mg + off + bj * 128) = w; } }
    }
};
struct EpiResid {
    static constexpr bool PERM = false, AFTER_DRAIN = false;
    const float* base; float* out; const float* gate;
    __device__ __forceinline__ void operator()(const f32x4 (&acc)[2][2][4][2], const pg8::Unit& u, int wr, int wc, int fr, int fq) const {
        const int row0 = u.pm * 256 + wr * 64 + fr, col0 = u.pn * 256 + wc * 32 + 4 * fq;
        const float* gp = gate + (size_t)((u.pm * 256) / SEQ) * NMOD + col0;
        f32x4 gv[2][2];
#pragma unroll
        for (int bj = 0; bj < 2; ++bj)
#pragma unroll
            for (int n = 0; n < 2; ++n) gv[bj][n] = *(const f32x4*)(gp + bj * 128 + n * 16);
#pragma unroll
        for (int ai = 0; ai < 2; ++ai)
#pragma unroll
            for (int m = 0; m < 4; ++m) { const size_t off = (size_t)(row0 + ai * 128 + m * 16) * D + col0;
#pragma unroll
                for (int bj = 0; bj < 2; ++bj)
#pragma unroll
                    for (int n = 0; n < 2; ++n) { const f32x4 bs = *(const f32x4*)(base + off + bj * 128 + n * 16);
                        *(f32x4*)(out + off + bj * 128 + n * 16) = bs * DN_ALPHA + gv[bj][n] * acc[ai][bj][m][n]; } }
    }
};

__device__ __forceinline__ void p0_transpose_item(const float* W, int K, int N, bf16_t* WT, LAS float* scr, int item, int lane) {
    const int nblk = N / 32, kb = item / nblk, nb = item % nblk, k0 = 64 * kb, n0 = 32 * nb;
#pragma unroll 8
    for (int i = 0; i < 32; ++i) { const int kk = 2 * i + (lane >> 5); scr[kk * 33 + (lane & 31)] = W[(size_t)(k0 + kk) * N + n0 + (lane & 31)]; }
    LDS_WAIT(); asm volatile("" ::: "memory");
    const int c = lane & 7;
#pragma unroll
    for (int j = 0; j < 4; ++j) { const int n = (lane >> 3) + 8 * j; const LAS float* s = scr + (8 * c) * 33 + n;
        u32x4 o; o.x = cvt_pk_bf16(s[0 * 33], s[1 * 33]); o.y = cvt_pk_bf16(s[2 * 33], s[3 * 33]); o.z = cvt_pk_bf16(s[4 * 33], s[5 * 33]); o.w = cvt_pk_bf16(s[6 * 33], s[7 * 33]);
        *(u32x4*)(WT + (size_t)(n0 + n) * K + k0 + 8 * c) = o; }
    LDS_WAIT(); asm volatile("" ::: "memory");
}
__device__ __forceinline__ float siluf_(float x) { return x / (1.0f + __expf(-x)); }

__device__ __forceinline__ void phase_prep(const Params& p, LAS unsigned char* L, int G, int bid, int wave, int lane) {
    LAS float* scr = (LAS float*)(L + wave * 16384);
    unsigned char* ws = p.ws;
    constexpr int I_IN = 16 * 176, I_UP = 16 * 176, I_DN = 44 * 32, I_BR = 16 * 32, I_BP = 8 * 32, I_OUT = 16 * 32, I_PW1 = 2 * 4, I_MOD = (NMOD / 64) * KSPLIT;
    constexpr int NITEMS = I_IN + I_UP + I_DN + I_BR + I_BP + I_OUT + 4 * I_PW1 + I_MOD;
    const int gw = bid * NWAVES + wave, NGW = G * NWAVES;
    for (int it = gw; it < NITEMS; it += NGW) {
        int r = it;
        if (r < I_IN) { p0_transpose_item(p.in[I_WIN], D, INW, (bf16_t*)(ws + WS_WIN), scr, r, lane); continue; } r -= I_IN;
        if (r < I_UP) { p0_transpose_item(p.in[I_WUP], D, UPW, (bf16_t*)(ws + WS_WUP), scr, r, lane); continue; } r -= I_UP;
        if (r < I_DN) { p0_transpose_item(p.in[I_WDN], DFF, D, (bf16_t*)(ws + WS_WDN), scr, r, lane); continue; } r -= I_DN;
        if (r < I_BR) { p0_transpose_item(p.in[I_WBR], D, D, (bf16_t*)(ws + WS_WBR), scr, r, lane); continue; } r -= I_BR;
        if (r < I_BP) { p0_transpose_item(p.in[I_WBP], 512, D, (bf16_t*)(ws + WS_WBP), scr, r, lane); continue; } r -= I_BP;
        if (r < I_OUT) { p0_transpose_item(p.in[I_WOUT], D, D, (bf16_t*)(ws + WS_WOUT), scr, r, lane); continue; } r -= I_OUT;
        if (r < 4 * I_PW1) { const int gi = r / I_PW1; p0_transpose_item(p.in[I_POOLW] + (size_t)gi * 128 * 128, 128, 128, (bf16_t*)(ws + WS_PW) + (size_t)gi * 128 * 128, scr, r % I_PW1, lane); continue; } r -= 4 * I_PW1;
        {
            const int jg = r / KSPLIT, ks = r % KSPLIT, j = 64 * jg + lane, kb = 128 * ks;
            const float* wa = p.in[I_WADA] + (size_t)kb * NMOD + j;
            float a0 = 0.f, a1 = 0.f, a2 = 0.f;
#pragma unroll
            for (int hh = 0; hh < 2; ++hh) {
                const int k = kb + 64 * hh + lane;
                const float s0 = siluf_(p.in[I_C][k]), s1 = siluf_(p.in[I_C][D + k]), s2 = siluf_(p.in[I_CCTX][k]);
#pragma unroll 16
                for (int kk = 0; kk < 64; ++kk) {
                    const float w = wa[(size_t)(64 * hh + kk) * NMOD];
                    a0 += __shfl(s0, kk) * w; a1 += __shfl(s1, kk) * w; a2 += __shfl(s2, kk) * w;
                }
            }
            float* part = (float*)(ws + WS_MODP) + (size_t)ks * 3 * NMOD + j;
            part[0] = a0; part[NMOD] = a1; part[2 * NMOD] = a2;
        }
    }
}

__device__ __forceinline__ void row_stats(const f32x4 (&v)[4], float& mean, float& rstd) {
    float s = 0.f;
#pragma unroll
    for (int j = 0; j < 4; ++j) s += (v[j].x + v[j].y) + (v[j].z + v[j].w);
    mean = wave_sum(s) * (1.f / D); float s2 = 0.f;
#pragma unroll
    for (int j = 0; j < 4; ++j) { const f32x4 d = v[j] - mean; s2 += (d.x * d.x + d.y * d.y) + (d.z * d.z + d.w * d.w); }
    rstd = 1.f / sqrtf(wave_sum(s2) * (1.f / D) + LN_EPS);
}
__device__ __forceinline__ void phase_mod1(const Params& p, LAS unsigned char* L, int G, int bid, int tid, int wave, int lane) {
    unsigned char* ws = p.ws;
    const float* part = (const float*)(ws + WS_MODP); const float* bada = p.in[I_BADA];
    LAS float* T = (LAS float*)L;
    for (int idx = tid; idx < 3 * 2048; idx += NTHR) { const int v = idx / 2048, j = idx % 2048; float s = bada[j];
#pragma unroll
        for (int ks = 0; ks < KSPLIT; ++ks) s += part[((size_t)ks * 3 + v) * NMOD + j];
        T[idx] = s; }
    float* MOD = (float*)(ws + WS_MOD);
    for (int idx = bid * NTHR + tid; idx < 3 * NMOD; idx += G * NTHR) { const int v = idx / NMOD, j = idx % NMOD; float s = bada[j];
#pragma unroll
        for (int ks = 0; ks < KSPLIT; ++ks) s += part[((size_t)ks * 3 + v) * NMOD + j];
        MOD[idx] = s; }
    __syncthreads();
    const int gw = bid * NWAVES + wave, NGW = G * NWAVES;
    for (int m = gw; m < MTOK + MCTX; m += NGW) {
        const int v = m < SEQ ? 0 : (m < MTOK ? 1 : 2);
        const float* xr = m < MTOK ? p.in[I_X] + (size_t)m * D : p.in[I_CTX] + (size_t)(m - MTOK) * D;
        bf16_t* orow = m < MTOK ? (bf16_t*)(ws + WS_U) + (size_t)m * D : (bf16_t*)(ws + WS_UC) + (size_t)(m - MTOK) * D;
        f32x4 x[4];
#pragma unroll
        for (int j = 0; j < 4; ++j) x[j] = *((const f32x4*)xr + lane + 64 * j);
        float mean, rstd; row_stats(x, mean, rstd);
#pragma unroll
        for (int j = 0; j < 4; ++j) { const int col = 256 * j + 4 * lane;
            const f32x4 sh = *(const LAS f32x4*)(T + v * 2048 + col), sc = *(const LAS f32x4*)(T + v * 2048 + 1024 + col);
            const f32x4 o = (x[j] - mean) * rstd * (sc + 1.0f) + sh;
            u32x2 w; w.x = cvt_pk_bf16(o.x, o.y); w.y = cvt_pk_bf16(o.z, o.w);
            *((u32x2*)orow + lane + 64 * j) = w; }
    }
    __syncthreads();
}

__device__ __forceinline__ int ti_off(int row, int j) { return row * 272 + ((((j >> 2) ^ ((row >> 3) & 15))) << 3) + (j & 3) * 2; }
__device__ __forceinline__ int ti_blk(int row, int blk) { return row * 272 + ((blk ^ ((row >> 3) & 15)) << 3); }
__device__ __forceinline__ float log2_gamma(const float* logit, int dir, int h) {
    const float x = logit[dir * HEADS + h];
    return -log1pf(expf(-x)) * 1.4426950408889634f;
}
__device__ __forceinline__ void stage_vt(const bf16_t* src, int ld, LAS unsigned char* VT, int tid) {
#pragma unroll
    for (int it = 0; it < 4; ++it) { const int q = tid + NTHR * it, j = q >> 4, c = q & 15;
        const u32x4 w = *(const u32x4*)(src + (size_t)j * ld + 8 * c);
        const unsigned ww[4] = {w.x, w.y, w.z, w.w};
#pragma unroll
        for (int i = 0; i < 4; ++i) {
            *(LAS unsigned short*)(VT + ti_off(8 * c + 2 * i, j)) = (unsigned short)(ww[i] & 0xffffu);
            *(LAS unsigned short*)(VT + ti_off(8 * c + 2 * i + 1, j)) = (unsigned short)(ww[i] >> 16); } }
}

__device__ __forceinline__ void phase_kvsum(const Params& p, LAS unsigned char* L, int G, int bid, int tid, int wave, int lane) {
    unsigned char* ws = p.ws;
    LAS unsigned char* VT = L; LAS unsigned char* KTf = L + 34816; LAS unsigned char* KTb = L + 34816 + 17408;
    for (int un = bid; un < BATCH * HEADS * (NCH + 2); un += G) {
        asm volatile("" : "+v"(tid), "+v"(lane));
        const int r = lane & 15, g = lane >> 4;
        const int n = un % (NCH + 2), bh = un / (NCH + 2), h = bh % HEADS, b = bh / HEADS;
        const bf16_t* src; int ld; bf16_t *of, *ob;
        if (n < NCH) { src = (const bf16_t*)(ws + WS_PROJ) + (size_t)(b * SEQ + n * 128) * INW; ld = INW;
            of = (bf16_t*)(ws + WS_KVF) + ((size_t)bh * NCH + n) * 8192; ob = (bf16_t*)(ws + WS_KVB) + ((size_t)bh * NCH + n) * 8192; }
        else { const int ci = n - NCH; src = (const bf16_t*)(ws + WS_PROJC) + (size_t)(b * CTXL + ci * 128) * KVC; ld = KVC;
            of = (bf16_t*)(ws + WS_CKV) + (((size_t)bh * 2 + ci) * 2 + 0) * 8192; ob = of + 8192; }
        const float lgf = log2_gamma(p.in[I_DECAY], 0, h), lgb = log2_gamma(p.in[I_DECAY], 1, h);
        stage_vt(src + C_V + 128 * h, ld, VT, tid);
#pragma unroll
        for (int it = 0; it < 2; ++it) { const int q = tid + NTHR * it, j = q >> 3, c = q & 7;
            const u32x4 w = *(const u32x4*)(src + (size_t)j * ld + C_K + 64 * h + 8 * c);
            const float wf = exp2f(lgf * (float)(127 - j)) * 0.125f, wb = exp2f(lgb * (float)j) * 0.125f;
            const unsigned ww[4] = {w.x, w.y, w.z, w.w};
#pragma unroll
            for (int i = 0; i < 4; ++i) { const float lo = bflo(ww[i]), hi = bfhi(ww[i]);
                *(LAS unsigned short*)(KTf + ti_off(8 * c + 2 * i, j)) = (unsigned short)f2bf(lo * wf);
                *(LAS unsigned short*)(KTf + ti_off(8 * c + 2 * i + 1, j)) = (unsigned short)f2bf(hi * wf);
                *(LAS unsigned short*)(KTb + ti_off(8 * c + 2 * i, j)) = (unsigned short)f2bf(lo * wb);
                *(LAS unsigned short*)(KTb + ti_off(8 * c + 2 * i + 1, j)) = (unsigned short)f2bf(hi * wb); } }
        __syncthreads();
        f32x4 aF[4], aB[4];
#pragma unroll
        for (int t = 0; t < 4; ++t) { aF[t] = (f32x4){0.f, 0.f, 0.f, 0.f}; aB[t] = (f32x4){0.f, 0.f, 0.f, 0.f}; }
        const int e = 16 * wave + r;
#pragma unroll
        for (int u = 0; u < 4; ++u) {
            const bf16x8 bv = mk8(*(const LAS u32x2*)(VT + ti_blk(e, 8 * u + g)), *(const LAS u32x2*)(VT + ti_blk(e, 8 * u + 4 + g)));
#pragma unroll
            for (int t = 0; t < 4; ++t) { const int d = 16 * t + r;
                const bf16x8 af = mk8(*(const LAS u32x2*)(KTf + ti_blk(d, 8 * u + g)), *(const LAS u32x2*)(KTf + ti_blk(d, 8 * u + 4 + g)));
                const bf16x8 ab = mk8(*(const LAS u32x2*)(KTb + ti_blk(d, 8 * u + g)), *(const LAS u32x2*)(KTb + ti_blk(d, 8 * u + 4 + g)));
                aF[t] = MFMA16(af, bv, aF[t]); aB[t] = MFMA16(ab, bv, aB[t]); }
        }
#pragma unroll
        for (int t = 0; t < 4; ++t) { u32x2 w; w.x = cvt_pk_bf16(aF[t][0], aF[t][1]); w.y = cvt_pk_bf16(aF[t][2], aF[t][3]);
            *(u32x2*)(of + (size_t)e * 64 + 16 * t + 4 * g) = w;
            w.x = cvt_pk_bf16(aB[t][0], aB[t][1]); w.y = cvt_pk_bf16(aB[t][2], aB[t][3]);
            *(u32x2*)(ob + (size_t)e * 64 + 16 * t + 4 * g) = w; }
        __syncthreads();
    }
}

template <bool DUP = false> __device__ __forceinline__ void phase_scan(const Params& p, int G, int bid, int tid) {
    unsigned char* ws = p.ws;
    for (int item = bid * NTHR + tid; item < 2 * 65536; item += G * NTHR) {
        const int dir = item >> 16, rem = item & 65535, bh = rem >> 12, pi = rem & 4095, h = bh % HEADS;
        const float dec = exp2f(128.0f * log2_gamma(p.in[I_DECAY], dir, h));
        const bf16_t* ck = (const bf16_t*)(ws + WS_CKV);
        const unsigned c0 = *(const unsigned*)(ck + (((size_t)bh * 2 + 0) * 2 + dir) * 8192 + 2 * pi), c1 = *(const unsigned*)(ck + (((size_t)bh * 2 + 1) * 2 + dir) * 8192 + 2 * pi);
        float s0, s1;
        if (dir == 0) { s0 = dec * bflo(c0) + bflo(c1); s1 = dec * bfhi(c0) + bfhi(c1); }
        else          { s0 = bflo(c0) + dec * bflo(c1); s1 = bfhi(c0) + dec * bfhi(c1); }
        unsigned* base = (unsigned*)((bf16_t*)(ws + (dir == 0 ? WS_KVF : WS_KVB)) + (size_t)bh * NCH * 8192 + 2 * pi);
        for (int n0 = 0; n0 < NCH; n0 += 8) {
            unsigned t[8];
#pragma unroll
            for (int i = 0; i < 8; ++i) { const int n = dir == 0 ? n0 + i : NCH - 1 - (n0 + i); t[i] = base[(size_t)n * 4096]; }
#pragma unroll
            for (int i = 0; i < 8; ++i) { const int n = dir == 0 ? n0 + i : NCH - 1 - (n0 + i);
                if (!DUP) base[(size_t)n * 4096] = cvt_pk_bf16(s0, s1);
                s0 = dec * s0 + bflo(t[i]); s1 = dec * s1 + bfhi(t[i]); }
        }
        if (DUP) *(unsigned*)(ws + 72 * MiB + (size_t)item * 4) = cvt_pk_bf16(s0, s1);
    }
}

template <bool DUP = false> __device__ __forceinline__ void ret_unit(const Params& p, LAS unsigned char* L, int un, int tid, int wave, int lane) {
    asm volatile("" : "+v"(tid), "+v"(lane));
    unsigned char* ws = p.ws;
    LAS unsigned char* Qs = L; LAS unsigned char* Ks = L + 18432; LAS unsigned char* VT = L + 36864; LAS unsigned char* SF = L + 71680; LAS unsigned char* SB = L + 90112;
    const int n = un % NCH, bh = un / NCH, h = bh % HEADS, b = bh / HEADS;
    bf16_t* proj = (bf16_t*)(ws + WS_PROJ) + (size_t)(b * SEQ + n * 128) * INW;
    const bf16_t* sf = (const bf16_t*)(ws + WS_KVF) + ((size_t)bh * NCH + n) * 8192; const bf16_t* sb = (const bf16_t*)(ws + WS_KVB) + ((size_t)bh * NCH + n) * 8192;
    const float lgf = log2_gamma(p.in[I_DECAY], 0, h), lgb = log2_gamma(p.in[I_DECAY], 1, h);
    stage_vt(proj + C_V + 128 * h, INW, VT, tid);
#pragma unroll
    for (int it = 0; it < 2; ++it) { const int q = tid + NTHR * it, j = q >> 3, c = q & 7;
        *(LAS u32x4*)(Qs + j * 144 + c * 16) = *(const u32x4*)(proj + (size_t)j * INW + C_Q + 64 * h + 8 * c);
        *(LAS u32x4*)(Ks + j * 144 + c * 16) = *(const u32x4*)(proj + (size_t)j * INW + C_K + 64 * h + 8 * c);
        *(LAS u32x4*)(SF + j * 144 + c * 16) = *(const u32x4*)(sf + (size_t)q * 8);
        *(LAS u32x4*)(SB + j * 144 + c * 16) = *(const u32x4*)(sb + (size_t)q * 8); }
    __syncthreads();
    const int r = lane & 15, g = lane >> 4, il = 16 * wave + r;
    bf16x8 qf[2];
#pragma unroll
    for (int u = 0; u < 2; ++u) qf[u] = *(const LAS bf16x8*)(Qs + il * 144 + (32 * u + 8 * g) * 2);
    bf16x8 pf[4];
    {
        f32x4 aS[8];
#pragma unroll
        for (int t = 0; t < 8; ++t) { aS[t] = (f32x4){0.f, 0.f, 0.f, 0.f};
#pragma unroll
            for (int u = 0; u < 2; ++u) { const bf16x8 kf = *(const LAS bf16x8*)(Ks + (16 * t + r) * 144 + (32 * u + 8 * g) * 2); aS[t] = MFMA16(kf, qf[u], aS[t]); }
            if (t & 1) __builtin_amdgcn_sched_barrier(0); }
        unsigned pk[8][2];
#pragma unroll
        for (int t = 0; t < 8; ++t) { float pv[4];
#pragma unroll
            for (int i4 = 0; i4 < 4; ++i4) { const int j = 16 * t + 4 * g + i4, dl = il - j;
                const float dc = dl > 0 ? exp2f(lgf * (float)dl) : (dl < 0 ? exp2f(lgb * (float)(-dl)) : 2.0f);
                pv[i4] = aS[t][i4] * 0.125f * dc; }
            pk[t][0] = cvt_pk_bf16(pv[0], pv[1]); pk[t][1] = cvt_pk_bf16(pv[2], pv[3]); }
#pragma unroll
        for (int u = 0; u < 4; ++u) { u32x4 w = {pk[2 * u][0], pk[2 * u][1], pk[2 * u + 1][0], pk[2 * u + 1][1]}; pf[u] = __builtin_bit_cast(bf16x8, w); }
    }
    const float qdf = exp2f(lgf * (float)(il + 1)), qdb = exp2f(lgb * (float)(128 - il));
    bf16x8 qF[2], qB[2];
#pragma unroll
    for (int u = 0; u < 2; ++u) { const u32x4 w = __builtin_bit_cast(u32x4, qf[u]); u32x4 a, c;
        a.x = cvt_pk_bf16(bflo(w.x) * qdf, bfhi(w.x) * qdf); a.y = cvt_pk_bf16(bflo(w.y) * qdf, bfhi(w.y) * qdf); a.z = cvt_pk_bf16(bflo(w.z) * qdf, bfhi(w.z) * qdf); a.w = cvt_pk_bf16(bflo(w.w) * qdf, bfhi(w.w) * qdf);
        c.x = cvt_pk_bf16(bflo(w.x) * qdb, bfhi(w.x) * qdb); c.y = cvt_pk_bf16(bflo(w.y) * qdb, bfhi(w.y) * qdb); c.z = cvt_pk_bf16(bflo(w.z) * qdb, bfhi(w.z) * qdb); c.w = cvt_pk_bf16(bflo(w.w) * qdb, bfhi(w.w) * qdb);
        qF[u] = __builtin_bit_cast(bf16x8, a); qB[u] = __builtin_bit_cast(bf16x8, c); }
    f32x4 aO[8];
    float s = 0.f;
#pragma unroll
    for (int te = 0; te < 8; ++te) { aO[te] = (f32x4){0.f, 0.f, 0.f, 0.f};
        const int e = 16 * te + r;
#pragma unroll
        for (int u = 0; u < 4; ++u) { const bf16x8 vf = mk8(*(const LAS u32x2*)(VT + ti_blk(e, 8 * u + g)), *(const LAS u32x2*)(VT + ti_blk(e, 8 * u + 4 + g))); aO[te] = MFMA16(vf, pf[u], aO[te]); }
#pragma unroll
        for (int u = 0; u < 2; ++u) { const bf16x8 s1 = *(const LAS bf16x8*)(SF + e * 144 + (32 * u + 8 * g) * 2), s2 = *(const LAS bf16x8*)(SB + e * 144 + (32 * u + 8 * g) * 2);
            aO[te] = MFMA16(s1, qF[u], aO[te]); aO[te] = MFMA16(s2, qB[u], aO[te]); }
        s += (aO[te][0] + aO[te][1]) + (aO[te][2] + aO[te][3]);
        __builtin_amdgcn_sched_barrier(0); }
    s += __shfl_xor(s, 16); s += __shfl_xor(s, 32);
    const float mean = s * (1.0f / 128.0f); float q2 = 0.f;
#pragma unroll
    for (int te = 0; te < 8; ++te) { const f32x4 d = aO[te] - mean; q2 += (d[0] * d[0] + d[1] * d[1]) + (d[2] * d[2] + d[3] * d[3]); }
    q2 += __shfl_xor(q2, 16); q2 += __shfl_xor(q2, 32);
    const float rstd = 1.0f / sqrtf(q2 * (1.0f / 128.0f) + LN_EPS);
    bf16_t* grow = proj + (size_t)il * INW + C_G + 128 * h + 4 * g;
#pragma unroll
    for (int te = 0; te < 8; ++te) { const u32x2 gw = *(const u32x2*)(grow + 16 * te);
        const float g0 = bflo(gw.x), g1 = bfhi(gw.x), g2 = bflo(gw.y), g3 = bfhi(gw.y);
        const f32x4 y = (aO[te] - mean) * rstd;
        u32x2 w; w.x = cvt_pk_bf16(y[0] * siluf_(g0), y[1] * siluf_(g1)); w.y = cvt_pk_bf16(y[2] * siluf_(g2), y[3] * siluf_(g3));
        if (DUP) *(u32x2*)((bf16_t*)(ws + 72 * MiB) + (size_t)blockIdx.x * 16384 + il * 128 + 4 * g + 16 * te) = w; else *(u32x2*)(grow + 16 * te) = w; }
    __syncthreads();
}

__device__ __forceinline__ void pool_unit(const Params& p, LAS unsigned char* L, int un, int tid, int wave, int lane) {
    asm volatile("" : "+v"(tid), "+v"(lane));
    unsigned char* ws = p.ws;
    LAS unsigned char* Ps = L; LAS unsigned char* Ds = L + 39168; LAS unsigned char* Wt = L + 73984;
    const int gi = un & 3, tt = un >> 2, b = tt / NCH, t0 = (tt % NCH) * 128, hw = 1 << gi;
    const bf16_t* proj = (const bf16_t*)(ws + WS_PROJ) + (size_t)(b * SEQ) * INW + C_P + 128 * gi;
    for (int q = tid; q < 144 * 16; q += NTHR) { const int rr = q >> 4, c = q & 15, t = t0 - 8 + rr;
        u32x4 w = {0u, 0u, 0u, 0u};
        if (t >= 0 && t < SEQ) w = *(const u32x4*)(proj + (size_t)t * INW + 8 * c);
        *(LAS u32x4*)(Ps + rr * 272 + c * 16) = w; }
    const bf16_t* pw = (const bf16_t*)(ws + WS_PW) + (size_t)gi * 128 * 128;
#pragma unroll
    for (int it = 0; it < 4; ++it) { const int q = tid + NTHR * it, rr = q >> 4, c = q & 15;
        *(LAS u32x4*)(Wt + rr * 272 + c * 16) = *(const u32x4*)(pw + (size_t)q * 8); }
    __syncthreads();
#pragma unroll
    for (int it = 0; it < 4; ++it) { const int q = tid + NTHR * it, i = q >> 4, c = q & 15, t = t0 + i;
        float a[8];
#pragma unroll
        for (int k = 0; k < 8; ++k) a[k] = 0.f;
        int cnt = 0;
        for (int kk = 0; kk < 2 * hw; ++kk) { const int t2 = t - hw + kk;
            if (t2 >= 0 && t2 < SEQ) { const u32x4 w = *(const LAS u32x4*)(Ps + (t2 - t0 + 8) * 272 + c * 16); ++cnt;
                a[0] += bflo(w.x); a[1] += bfhi(w.x); a[2] += bflo(w.y); a[3] += bfhi(w.y); a[4] += bflo(w.z); a[5] += bfhi(w.z); a[6] += bflo(w.w); a[7] += bfhi(w.w); } }
        const u32x4 cw = *(const LAS u32x4*)(Ps + (i + 8) * 272 + c * 16);
        const float inv = 1.0f / (float)cnt;
        u32x4 o; o.x = cvt_pk_bf16(a[0] * inv - bflo(cw.x), a[1] * inv - bfhi(cw.x)); o.y = cvt_pk_bf16(a[2] * inv - bflo(cw.y), a[3] * inv - bfhi(cw.y));
        o.z = cvt_pk_bf16(a[4] * inv - bflo(cw.z), a[5] * inv - bfhi(cw.z)); o.w = cvt_pk_bf16(a[6] * inv - bflo(cw.w), a[7] * inv - bfhi(cw.w));
        *(LAS u32x4*)(Ds + i * 272 + c * 16) = o; }
    __syncthreads();
    const int r = lane & 15, g = lane >> 4, il = 16 * wave + r;
    bf16x8 df[4];
#pragma unroll
    for (int u = 0; u < 4; ++u) df[u] = *(const LAS bf16x8*)(Ds + il * 272 + (32 * u + 8 * g) * 2);
    bf16_t* orow = (bf16_t*)(ws + WS_POOL) + (size_t)(b * SEQ + t0 + il) * 512 + 128 * gi + 4 * g;
    const float* psc = p.in[I_POOLS] + 128 * gi + 4 * g;
#pragma unroll
    for (int tn = 0; tn < 8; ++tn) { f32x4 acc = {0.f, 0.f, 0.f, 0.f};
#pragma unroll
        for (int u = 0; u < 4; ++u) { const bf16x8 wf = *(const LAS bf16x8*)(Wt + (16 * tn + r) * 272 + (32 * u + 8 * g) * 2); acc = MFMA16(wf, df[u], acc); }
        const f32x4 sc = *(const f32x4*)(psc + 16 * tn);
        u32x2 w; w.x = cvt_pk_bf16(acc[0] * sc[0], acc[1] * sc[1]); w.y = cvt_pk_bf16(acc[2] * sc[2], acc[3] * sc[3]);
        *(u32x2*)(orow + 16 * tn) = w; }
    __syncthreads();
}

template <bool WITH_MOD> __device__ __forceinline__ void phase_postnorm(const Params& p, float* io, const float* gam, const float* bet, int G, int bid, int wave, int lane) {
    const int gw = bid * NWAVES + wave, NGW = G * NWAVES;
    const float* MOD = (const float*)(p.ws + WS_MOD);
    for (int m = gw; m < MTOK; m += NGW) {
        f32x4* row = (f32x4*)(io + (size_t)m * D);
        f32x4 x[4];
#pragma unroll
        for (int j = 0; j < 4; ++j) x[j] = row[lane + 64 * j];
        float mean, rstd; row_stats(x, mean, rstd);
#pragma unroll
        for (int j = 0; j < 4; ++j) { const f32x4 gg = *((const f32x4*)gam + lane + 64 * j), bb = *((const f32x4*)bet + lane + 64 * j);
            x[j] = (x[j] - mean) * rstd * gg + bb; row[lane + 64 * j] = x[j]; }
        if (WITH_MOD) {
            row_stats(x, mean, rstd);
            const float* mb = MOD + (size_t)(m / SEQ) * NMOD;
            bf16_t* orow = (bf16_t*)(p.ws + WS_U) + (size_t)m * D;
#pragma unroll
            for (int j = 0; j < 4; ++j) { const f32x4 sh = *((const f32x4*)(mb + 3 * D) + lane + 64 * j), sc = *((const f32x4*)(mb + 4 * D) + lane + 64 * j);
                const f32x4 o = (x[j] - mean) * rstd * (sc + 1.0f) + sh;
                u32x2 w; w.x = cvt_pk_bf16(o.x, o.y); w.y = cvt_pk_bf16(o.z, o.w);
                *((u32x2*)orow + lane + 64 * j) = w; }
        }
    }
}

__device__ __forceinline__ float gelu_tanh(float x) { const float u = 0.7978845608028654f * (x + 0.044715f * x * x * x); return x / (1.0f + __expf(-2.0f * u)); }
__device__ __forceinline__ void conv_pass(const bf16_t* Hb, int chan, const float* cw, const float* cb, int y, int x0, f32x4 (&res)[4]) {
    u32x2 v[3][6];
#pragma unroll
    for (int dy = 0; dy < 3; ++dy) { const int yy = y + dy - 1, yc = yy < 0 ? 0 : (yy > 127 ? 127 : yy);
#pragma unroll
        for (int cx = 0; cx < 6; ++cx) { const int xx = x0 - 1 + cx, xc = xx < 0 ? 0 : (xx > 63 ? 63 : xx);
            v[dy][cx] = *(const u32x2*)((const char*)Hb + (unsigned)(((yc * 64 + xc) * UPW + chan) * 2)); } }
    f32x4 w[9];
#pragma unroll
    for (int k = 0; k < 9; ++k) w[k] = *(const f32x4*)((const char*)cw + (unsigned)((k * UPW + chan) * 4));
    const f32x4 bias = *(const f32x4*)((const char*)cb + (unsigned)(chan * 4));
#pragma unroll
    for (int dy = 0; dy < 3; ++dy) { const int yy = y + dy - 1; const bool yok = (yy >= 0) && (yy < 128);
#pragma unroll
        for (int cx = 0; cx < 6; ++cx) { const int xx = x0 - 1 + cx; const bool ok = yok && (xx >= 0) && (xx < 64);
            v[dy][cx].x = ok ? v[dy][cx].x : 0u; v[dy][cx].y = ok ? v[dy][cx].y : 0u; } }
#pragma unroll
    for (int xi = 0; xi < 4; ++xi) { f32x4 a = bias;
#pragma unroll
        for (int dy = 0; dy < 3; ++dy)
#pragma unroll
            for (int dx = 0; dx < 3; ++dx) { const u32x2 t = v[dy][xi + dx]; const f32x4 ww = w[dy * 3 + dx];
                a[0] += bflo(t.x) * ww[0]; a[1] += bfhi(t.x) * ww[1]; a[2] += bflo(t.y) * ww[2]; a[3] += bfhi(t.y) * ww[3]; }
        res[xi] = a; }
}
__device__ __forceinline__ void phase_conv(const Params& p, int half, int G, int bid, int tid) {
    const bf16_t* Hh = (const bf16_t*)(p.ws + WS_H);
    bf16_t* HC = (bf16_t*)(p.ws + WS_HC) + (size_t)half * SEQ * DFF;
    const float* cw = p.in[I_CONVW]; const float* cb = p.in[I_CONVB];
    constexpr int NCK = DFF / 4, NITEM = 128 * 16 * NCK;
    for (int item = bid * NTHR + tid; item < NITEM; item += G * NTHR) {
        const int ck = item % NCK, xo = (item / NCK) & 15, y = item / (16 * NCK), ch = 4 * ck, x0 = 4 * xo;
        f32x4 ra[4], rb[4];
        conv_pass(Hh, ch, cw, cb, y, x0, ra);
#pragma unroll
        for (int xi = 0; xi < 4; ++xi) { ra[xi][0] = gelu_tanh(ra[xi][0]); ra[xi][1] = gelu_tanh(ra[xi][1]); ra[xi][2] = gelu_tanh(ra[xi][2]); ra[xi][3] = gelu_tanh(ra[xi][3]); }
        asm volatile("" ::: "memory"); __builtin_amdgcn_sched_barrier(0);
        conv_pass(Hh, DFF + ch, cw, cb, y, x0, rb);
#pragma unroll
        for (int xi = 0; xi < 4; ++xi) { u32x2 o; o.x = cvt_pk_bf16(ra[xi][0] * rb[xi][0], ra[xi][1] * rb[xi][1]); o.y = cvt_pk_bf16(ra[xi][2] * rb[xi][2], ra[xi][3] * rb[xi][3]);
            *(u32x2*)(HC + (size_t)(y * 64 + x0 + xi) * DFF + ch) = o; }
    }
}

#define XB_TMO      128
#define XB_XCNT(j)  (256  + 64 * (j))
#define XB_XSUB(j)  (1280 + 64 * (j))
#define XB_XGEN(j)  (2304 + 64 * (j))
#define XB_TOP      3328
#define XB_TOPGEN   3392
#define XCD_BAR_WORDS 3456
#define XB_SPIN_CAP (1u << 18)

__device__ __forceinline__ unsigned xb_ld(unsigned* p)              { return __hip_atomic_load(p, __ATOMIC_RELAXED, __HIP_MEMORY_SCOPE_AGENT); }
__device__ __forceinline__ unsigned xb_add(unsigned* p, unsigned v) { return __hip_atomic_fetch_add(p, v, __ATOMIC_RELAXED, __HIP_MEMORY_SCOPE_AGENT); }
__device__ __forceinline__ unsigned xb_xcc_id() { return (unsigned)__builtin_amdgcn_s_getreg((3 << 11) | 20) & 0xFu; }
#define XB_SPIN(cond, bar) do { unsigned _sp = 0; while (cond) { __builtin_amdgcn_s_sleep(1); \
    if ((++_sp & 255u) == 0u) { if (xb_ld(&(bar)[XB_TMO])) break; if (_sp > XB_SPIN_CAP) { atomicAdd(&(bar)[XB_TMO], 1u); break; } } } } while (0)

struct XcdBarrier {
    unsigned* bar; unsigned x;
    volatile LAS unsigned* st;
};

__device__ __forceinline__ XcdBarrier xcd_barrier_post(unsigned* bar, volatile LAS unsigned* st) {
    XcdBarrier b; b.bar = bar; b.x = xb_xcc_id(); b.st = st;
    if (threadIdx.x == 0) (void)xb_add(&bar[XB_XCNT(b.x)], 1u);
    return b;
}
__device__ __forceinline__ void xcd_barrier_complete(unsigned* bar, unsigned x, unsigned& nloc, unsigned& nx) {
    const unsigned G = gridDim.x * gridDim.y * gridDim.z;
    unsigned sum, cnt, mine, sp = 0u;
    for (;;) {
        sum = 0u; cnt = 0u; mine = 0u;
#pragma unroll
        for (unsigned j = 0; j < 16; ++j) { const unsigned c = xb_ld(&bar[XB_XCNT(j)]); sum += c; cnt += (c > 0u) ? 1u : 0u; mine = (j == x) ? c : mine; }
        if (sum == G) break;
        __builtin_amdgcn_s_sleep(1);
        if ((++sp & 255u) == 0u) { if (xb_ld(&bar[XB_TMO])) break; if (sp > XB_SPIN_CAP) { atomicAdd(&bar[XB_TMO], 1u); break; } }
    }
    nloc = mine > 0u ? mine : 1u; nx = cnt > 0u ? cnt : 1u;
}

__device__ __forceinline__ void xcd_barrier(const XcdBarrier& b) {
    asm volatile("s_waitcnt vmcnt(0)" ::: "memory");
    __syncthreads();
    if (threadIdx.x == 0) {
        unsigned* bar = b.bar;
        __builtin_amdgcn_s_waitcnt(0);
        unsigned nloc = b.st[0], nx = b.st[1];
        if (nloc == 0u) { xcd_barrier_complete(bar, b.x, nloc, nx); b.st[0] = nloc; b.st[1] = nx; }
        const unsigned old = xb_add(&bar[XB_XSUB(b.x)], 1u);
        const unsigned gen = old / nloc;
        if (old + 1u == (gen + 1u) * nloc) {
            __builtin_amdgcn_fence(__ATOMIC_RELEASE, "agent");
            asm volatile("s_waitcnt vmcnt(0)" ::: "memory");
            const unsigned og = xb_add(&bar[XB_TOP], 1u);
            const unsigned tg = og / nx;
            if (og + 1u == (tg + 1u) * nx) xb_add(&bar[XB_TOPGEN], 1u);
            else XB_SPIN(xb_ld(&bar[XB_TOPGEN]) == tg, bar);
            __builtin_amdgcn_fence(__ATOMIC_ACQUIRE, "agent");
            xb_add(&bar[XB_XGEN(b.x)], 1u);
            asm volatile("s_waitcnt vmcnt(0)" ::: "memory");
        } else {
            XB_SPIN(xb_ld(&bar[XB_XGEN(b.x)]) == gen, bar);
            __builtin_amdgcn_fence(__ATOMIC_ACQUIRE, "agent");
            asm volatile("s_waitcnt vmcnt(0)" ::: "memory");
        }
    }
    __syncthreads();
}

#ifndef PROBE_DUP_CONV
#define PROBE_DUP_CONV 0
#endif
#define PROBE_DUP_KV 0
#define PROBE_DUP_G1 0
#define PROBE_SYNCS 0
#define PROBE_DUP_SCAN 0
#define PROBE_DUP_RET 0
#define PROBE_DUP_POOL 0
#ifndef MK_COOP
#define MK_COOP 1
#endif
constexpr int NPHASE = 15;
__global__ void __launch_bounds__(NTHR, 2) hybrid_fwd(Params p) {
    extern __shared__ __attribute__((aligned(16))) unsigned char lds_raw[];
    LAS unsigned char* L = (LAS unsigned char*)lds_raw;
    const int tid = threadIdx.x, lane = tid & 63, wave = __builtin_amdgcn_readfirstlane(tid >> 6);
    const int G = gridDim.x, bid = blockIdx.x;
    unsigned char* ws = p.ws;
    const int lo = p.ph_lo, hi = p.ph_hi;
    volatile LAS unsigned* MISC = (volatile LAS unsigned*)(L + 131072);
    if (tid < 2) MISC[tid] = 0u;
    __syncthreads();
    XcdBarrier bar; bar.bar = (unsigned*)ws; bar.x = 0; bar.st = nullptr;
    if (hi - lo > 1) bar = xcd_barrier_post((unsigned*)ws, MISC);
    if (hi > NPHASE) cg::this_grid().sync();
#define IN(k) (lo <= (k) && (k) < hi)
#define SEAM(k) do { if (IN(k) && IN((k) + 1)) { xcd_barrier(bar); } } while (0)

    if (IN(0)) { phase_prep(p, L, G, bid, wave, lane); } SEAM(0);
#if PROBE_SYNCS
    for (int i = 0; i < PROBE_SYNCS; ++i) xcd_barrier(bar);
#endif
    if (IN(1)) { phase_mod1(p, L, G, bid, tid, wave, lane); } SEAM(1);
    if (IN(2)) {
#if PROBE_DUP_G1
        { pg8::Gemm g{(const bf16_t*)(ws + WS_U), (const bf16_t*)(ws + WS_WIN), D, MTOK, INW, D}; pg8::StaticOrder S; S.init(MTOK, INW, G, bid);
          EpiStoreBf16 E{(bf16_t*)(ws + WS_PROJ), INW}; pg8::gemm_phase<EpiStoreBf16, pg8::StaticOrder, true, true>(L, g, S, E); }
#endif
        { pg8::Gemm g{(const bf16_t*)(ws + WS_U), (const bf16_t*)(ws + WS_WIN), D, MTOK, INW, D}; pg8::StaticOrder S; S.init(MTOK, INW, G, bid);
          EpiStoreBf16 E{(bf16_t*)(ws + WS_PROJ), INW}; pg8::gemm_phase<EpiStoreBf16, pg8::StaticOrder, true, true>(L, g, S, E); }
        { pg8::Gemm g{(const bf16_t*)(ws + WS_UC), (const bf16_t*)(ws + WS_WIN), D, MCTX, KVC, D}; pg8::StaticOrder S; S.init(MCTX, KVC, G, G - 1 - bid);
          EpiStoreBf16 E{(bf16_t*)(ws + WS_PROJC), KVC}; pg8::gemm_phase<EpiStoreBf16, pg8::StaticOrder, true, true>(L, g, S, E); }
    } SEAM(2);
    if (IN(3)) { phase_kvsum(p, L, G, bid, tid, wave, lane);
#if PROBE_DUP_KV
        phase_kvsum(p, L, G, bid, tid, wave, lane);
#endif
    } SEAM(3);
    if (IN(4)) {
#if PROBE_DUP_SCAN
        phase_scan<true>(p, G, bid, tid);
#endif
        phase_scan(p, G, bid, tid); } SEAM(4);
    if (IN(5)) {
#if PROBE_DUP_RET
        for (int un = bid; un < BATCH * HEADS * NCH; un += G) ret_unit<true>(p, L, un, tid, wave, lane);
#endif
        for (int un = bid; un < BATCH * HEADS * NCH; un += G) ret_unit(p, L, un, tid, wave, lane);
        for (int un = bid; un < (MTOK / 128) * 4; un += G) pool_unit(p, L, un, tid, wave, lane);
#if PROBE_DUP_POOL
        for (int un = bid; un < (MTOK / 128) * 4; un += G) pool_unit(p, L, un, tid, wave, lane);
#endif
    } SEAM(5);
    if (IN(6)) {
        bf16_t* proj = (bf16_t*)(ws + WS_PROJ);
        { pg8::Gemm g{proj + C_G, (const bf16_t*)(ws + WS_WBR), INW, MTOK, D, D}; pg8::StaticOrder S; S.init(MTOK, D, G, bid);
          EpiGate<0> E{proj + C_GA, proj + C_GB, INW}; pg8::gemm_phase<EpiGate<0>, pg8::StaticOrder, true, true>(L, g, S, E); }
        { pg8::Gemm g{(const bf16_t*)(ws + WS_POOL), (const bf16_t*)(ws + WS_WBP), 512, MTOK, D, 512}; pg8::StaticOrder S; S.init(MTOK, D, G, bid);
          EpiGate<1> E{proj + C_GA, proj + C_GB, INW}; pg8::gemm_phase<EpiGate<1>, pg8::StaticOrder, true, true>(L, g, S, E); }
    } SEAM(6);
    if (IN(7)) {
        pg8::Gemm g{(const bf16_t*)(ws + WS_PROJ) + C_GA, (const bf16_t*)(ws + WS_WOUT), INW, MTOK, D, D}; pg8::StaticOrder S; S.init(MTOK, D, G, bid);
        EpiResid E{p.in[I_X], p.out, (const float*)(ws + WS_MOD) + 2 * D}; pg8::gemm_phase<EpiResid, pg8::StaticOrder, true, true>(L, g, S, E);
    } SEAM(7);
    if (IN(8)) { phase_postnorm<true>(p, p.out, p.in[I_LN1G], p.in[I_LN1B], G, bid, wave, lane); } SEAM(8);
#pragma unroll 1
    for (int half = 0; half < 2; ++half) {
        if (IN(9 + 2 * half)) {
            pg8::Gemm g{(const bf16_t*)(ws + WS_U) + (size_t)half * SEQ * D, (const bf16_t*)(ws + WS_WUP), D, SEQ, UPW, D}; pg8::StaticOrder S; S.init(SEQ, UPW, G, bid);
            EpiStoreBf16 E{(bf16_t*)(ws + WS_H), UPW}; pg8::gemm_phase<EpiStoreBf16, pg8::StaticOrder, true, true>(L, g, S, E);
        } SEAM(9 + 2 * half);
        if (IN(10 + 2 * half)) { phase_conv(p, half, G, bid, tid);
#if PROBE_DUP_CONV
            phase_conv(p, half, G, bid, tid);
#endif
        } SEAM(10 + 2 * half);
    }
    if (IN(13)) {
        pg8::Gemm g{(const bf16_t*)(ws + WS_HC), (const bf16_t*)(ws + WS_WDN), DFF, MTOK, D, DFF}; pg8::StaticOrder S; S.init(MTOK, D, G, bid);
        EpiResid E{p.out, p.out, (const float*)(ws + WS_MOD) + 5 * D}; pg8::gemm_phase<EpiResid, pg8::StaticOrder, true, true>(L, g, S, E);
    } SEAM(13);
    if (IN(14)) { phase_postnorm<false>(p, p.out, p.in[I_LN2G], p.in[I_LN2B], G, bid, wave, lane); }
#undef IN
#undef SEAM
}

extern "C" void kernel_launch(void* const* d_in, const int* in_sizes, int n_in, void* d_out, int out_size, void* d_ws, size_t ws_size, hipStream_t stream) {
    static int grid = 0;
    if (grid == 0) {
        if (n_in != 21 || in_sizes[0] != MTOK * D || out_size != MTOK * D || ws_size < WS_END) { fprintf(stderr, "kernel_launch: unexpected shapes (n_in %d, in0 %d, out %d, ws %zu); nothing launched\n", n_in, n_in > 0 ? in_sizes[0] : -1, out_size, ws_size); grid = -1; return; }
        int dev = 0, cus = 0, per_cu = 0;
        if (hipGetDevice(&dev) != hipSuccess || hipDeviceGetAttribute(&cus, hipDeviceAttributeMultiprocessorCount, dev) != hipSuccess) { grid = -1; return; }
        if (hipFuncSetAttribute((const void*)hybrid_fwd, hipFuncAttributeMaxDynamicSharedMemorySize, LDS_BYTES) != hipSuccess) { fprintf(stderr, "kernel_launch: hipFuncSetAttribute failed\n"); grid = -1; return; }
        if (hipOccupancyMaxActiveBlocksPerMultiprocessor(&per_cu, (const void*)hybrid_fwd, NTHR, LDS_BYTES) != hipSuccess || per_cu < 1) { fprintf(stderr, "kernel_launch: occupancy query says %d blocks per CU\n", per_cu); (void)hipGetLastError(); grid = -1; return; }
        grid = cus * per_cu; if (grid > 256) grid = 256;
    }
    if (grid < 0) return;
    if (hipMemsetAsync(d_ws, 0, 65536, stream) != hipSuccess) { fprintf(stderr, "kernel_launch: memset of the barrier words failed\n"); return; }
    Params a{};
    for (int i = 0; i < 21; ++i) a.in[i] = (const float*)d_in[i];
    a.out = (float*)d_out; a.ws = (unsigned char*)d_ws;
#if MK_COOP
    a.ph_lo = 0; a.ph_hi = NPHASE;
    void* args[] = {&a};
    hipError_t e = hipLaunchCooperativeKernel((const void*)hybrid_fwd, dim3(grid), dim3(NTHR), args, LDS_BYTES, stream);
    if (e != hipSuccess) fprintf(stderr, "kernel_launch: cooperative launch failed: %s (grid %d)\n", hipGetErrorString(e), grid);
#else
    for (int ph = 0; ph < NPHASE; ++ph) { a.ph_lo = ph; a.ph_hi = ph + 1; hipLaunchKernelGGL(hybrid_fwd, dim3(grid), dim3(NTHR), LDS_BYTES, stream, a); }
#endif
}
```
